# Optimizing an MI355X kernel written in HIP

```python
import math
import jax, jax.numpy as jnp
from jax import lax
import numpy as np

D_MODEL = 1024
BATCH = 2
SEQ = 8192
DEPTH = 4

N_MIXERS = 3
N_S5_LAYERS = (DEPTH + 2) // 3
N_HG_LAYERS = (DEPTH + 1) // 3
N_AT_LAYERS = DEPTH // 3

S5_WIDTH = D_MODEL
S5_GROUP = 16
S5_GROUPS = S5_WIDTH // S5_GROUP
S5_STATE = 64
DT_MIN = 1e-3
DT_MAX = 1e-1

HG_WIDTH = D_MODEL
HG_HEAD_DIM = 128
HG_HEADS = HG_WIDTH // HG_HEAD_DIM
HG_CHUNK = 64

AT_HEAD_DIM = 64
AT_Q_HEADS = D_MODEL // AT_HEAD_DIM
AT_KV_HEADS = 4
AT_GROUP = AT_Q_HEADS // AT_KV_HEADS
AT_Q_WIDTH = AT_Q_HEADS * AT_HEAD_DIM
AT_KV_WIDTH = AT_KV_HEADS * AT_HEAD_DIM
AT_QKV_WIDTH = AT_Q_WIDTH + 2 * AT_KV_WIDTH
WINDOW = 128
BLOCK = 128
ROPE_THETA = 10000.0

NORM_EPS = 1e-6

kernel_name = 'hybrid_s5_hgrn2_swa_trunk'


def rms_norm(x, g):
    xf = x.astype(jnp.float32)
    y = xf * lax.rsqrt(jnp.mean(xf * xf, axis=-1, keepdims=True) + NORM_EPS)
    return (y * g.astype(jnp.float32)).astype(x.dtype)


def _complex_scan_combine(e1, e2):
    a1r, a1i, b1r, b1i = e1
    a2r, a2i, b2r, b2i = e2
    return (a2r * a1r - a2i * a1i,
            a2r * a1i + a2i * a1r,
            a2r * b1r - a2i * b1i + b2r,
            a2r * b1i + a2i * b1r + b2i)


def s5_branch(h, w_in, lam_re, lam_im, log_dt, b_re, b_im, c_re, c_im, d_skip, w_glu, b_glu, w_out):
    bsz, seq, _ = h.shape
    proj = h @ w_in
    u, z = proj[..., :S5_WIDTH], proj[..., S5_WIDTH:]
    uf = u.astype(jnp.float32).reshape(bsz, seq, S5_GROUPS, S5_GROUP)
    lr = lam_re.astype(jnp.float32)
    li = lam_im.astype(jnp.float32)
    dt = jnp.exp(log_dt.astype(jnp.float32))[:, None]
    mag = jnp.exp(lr * dt)
    ar = mag * jnp.cos(li * dt)
    ai = mag * jnp.sin(li * dt)
    den = lr * lr + li * li
    qr = ((ar - 1.0) * lr + ai * li) / den
    qi = (ai * lr - (ar - 1.0) * li) / den
    br = b_re.astype(jnp.float32)
    bi = b_im.astype(jnp.float32)
    bbr = qr[..., None] * br - qi[..., None] * bi
    bbi = qr[..., None] * bi + qi[..., None] * br
    xr = jnp.einsum('blgh,gph->blgp', uf, bbr)
    xi = jnp.einsum('blgh,gph->blgp', uf, bbi)
    a_r = jnp.broadcast_to(ar, (1, seq) + ar.shape)
    a_i = jnp.broadcast_to(ai, (1, seq) + ai.shape)
    _, _, sr, si = lax.associative_scan(_complex_scan_combine, (a_r, a_i, xr, xi), axis=1)
    y = (jnp.einsum('ghp,blgp->blgh', c_re.astype(jnp.float32), sr)
         - jnp.einsum('ghp,blgp->blgh', c_im.astype(jnp.float32), si))
    y = y.reshape(bsz, seq, S5_WIDTH) + d_skip.astype(jnp.float32) * u.astype(jnp.float32)
    y = jax.nn.gelu(y).astype(h.dtype)
    y = y * jax.nn.sigmoid(y @ w_glu + b_glu)
    return (y * jax.nn.silu(z)) @ w_out


def hgrn2_lower_bounds(lb_logits):
    p = jax.nn.softmax(lb_logits.astype(jnp.float32), axis=0)
    return jnp.cumsum(p, axis=0) - p[0]


def _to_chunks(t):
    bsz, seq, nh, dh = t.shape
    return t.reshape(bsz, seq // HG_CHUNK, HG_CHUNK, nh, dh).transpose(1, 0, 3, 2, 4)


def _hgrn2_chunk_step(state, inp):
    q, k, v, logf = inp
    b = jnp.cumsum(logf, axis=2)
    o_inter = jnp.einsum('bhtk,bhkv->bhtv', q * jnp.exp(b), state)
    causal = jnp.tril(jnp.ones((HG_CHUNK, HG_CHUNK), dtype=bool))
    diff = b[:, :, :, None, :] - b[:, :, None, :, :]
    decay = jnp.exp(jnp.where(causal[:, :, None], diff, -jnp.inf))
    scores = jnp.einsum('bhtk,bhtsk,bhsk->bhts', q, decay, k)
    o_intra = jnp.einsum('bhts,bhsv->bhtv', scores, v)
    b_last = b[:, :, -1:, :]
    new_state = (jnp.exp(b_last[:, :, 0, :])[..., None] * state
                 + jnp.einsum('bhsk,bhsv->bhkv', k * jnp.exp(b_last - b), v))
    return new_state, o_inter + o_intra


def hgrn2_branch(h, w_in, lb, norm_g, w_out):
    bsz, seq, _ = h.shape
    proj = h @ w_in
    q, fz, i_in, z = jnp.split(proj, 4, axis=-1)
    f = lb + (1.0 - lb) * jax.nn.sigmoid(fz.astype(jnp.float32))
    logf = jnp.log(f)
    k = 1.0 - f
    heads = lambda t: _to_chunks(t.astype(jnp.float32).reshape(bsz, seq, HG_HEADS, HG_HEAD_DIM))
    s0 = jnp.zeros((bsz, HG_HEADS, HG_HEAD_DIM, HG_HEAD_DIM), jnp.float32)
    _, o = lax.scan(_hgrn2_chunk_step, s0, (heads(q), heads(k), heads(i_in), heads(logf)))
    o = o.transpose(1, 0, 3, 2, 4).reshape(bsz, seq, HG_HEADS, HG_HEAD_DIM)
    o = rms_norm(o, norm_g.reshape(HG_HEADS, HG_HEAD_DIM)).reshape(bsz, seq, HG_WIDTH).astype(h.dtype)
    return (o * jax.nn.silu(z)) @ w_out


def _rope(t, cos, sin):
    half = AT_HEAD_DIM // 2
    t1 = t[..., :half].astype(jnp.float32)
    t2 = t[..., half:].astype(jnp.float32)
    return jnp.concatenate([t1 * cos - t2 * sin, t2 * cos + t1 * sin], axis=-1).astype(t.dtype)


def swa_branch(h, positions, w_in, b_in, sinks, w_out):
    bsz, seq, _ = h.shape
    nb = seq // BLOCK
    proj = h @ w_in
    qkv = proj[..., :AT_QKV_WIDTH] + b_in
    z = proj[..., AT_QKV_WIDTH:]
    q = qkv[..., :AT_Q_WIDTH].reshape(bsz, seq, AT_Q_HEADS, AT_HEAD_DIM)
    k = qkv[..., AT_Q_WIDTH:AT_Q_WIDTH + AT_KV_WIDTH].reshape(bsz, seq, AT_KV_HEADS, AT_HEAD_DIM)
    v = qkv[..., AT_Q_WIDTH + AT_KV_WIDTH:].reshape(bsz, seq, AT_KV_HEADS, AT_HEAD_DIM)
    inv_freq = ROPE_THETA ** (-jnp.arange(0, AT_HEAD_DIM, 2, dtype=jnp.float32) / AT_HEAD_DIM)
    ang = positions.astype(jnp.float32)[..., None] * inv_freq
    cos = jnp.cos(ang)[:, :, None, :]
    sin = jnp.sin(ang)[:, :, None, :]
    q = _rope(q, cos, sin)
    k = _rope(k, cos, sin)
    qb = q.reshape(bsz, nb, BLOCK, AT_KV_HEADS, AT_GROUP, AT_HEAD_DIM)

    def band(t):
        t = t.reshape(bsz, nb, BLOCK, AT_KV_HEADS, AT_HEAD_DIM)
        prev = jnp.pad(t[:, :-1], ((0, 0), (1, 0), (0, 0), (0, 0), (0, 0)))
        return jnp.concatenate([prev, t], axis=2)

    kb, vb = band(k), band(v)
    s = jnp.einsum('bnqhgd,bnkhd->bnhgqk', qb, kb).astype(jnp.float32) * (AT_HEAD_DIM ** -0.5)
    qi = jnp.arange(BLOCK)[:, None]
    kj = jnp.arange(2 * BLOCK)[None, :]
    dist = qi + BLOCK - kj
    in_window = (dist >= 0) & (dist < WINDOW)
    has_prev = (jnp.arange(nb)[:, None, None] > 0) | (kj >= BLOCK)[None]
    mask = in_window[None] & has_prev
    s = jnp.where(mask[None, :, None, None], s, -jnp.inf)
    sink = sinks.astype(jnp.float32).reshape(AT_KV_HEADS, AT_GROUP)[None, None, :, :, None, None]
    m = jnp.maximum(jnp.max(s, axis=-1, keepdims=True), sink)
    e = jnp.exp(s - m)
    p = e / (jnp.sum(e, axis=-1, keepdims=True) + jnp.exp(sink - m))
    o = jnp.einsum('bnhgqk,bnkhd->bnqhgd', p.astype(vb.dtype), vb).reshape(bsz, seq, AT_Q_WIDTH)
    return (o * jax.nn.silu(z)) @ w_out


def setup_inputs(seed: int = 0) -> dict:
    key = jax.random.key(seed)
    ks = iter(jax.random.split(key, 32))

    def nrm(shape, scale):
        return jax.random.normal(next(ks), shape, jnp.float32) * scale

    x = nrm((BATCH, SEQ, D_MODEL), 1.0)
    offset = jax.random.randint(next(ks), (BATCH, 1), 0, 4096, dtype=jnp.int32)
    positions = (offset + jnp.arange(SEQ, dtype=jnp.int32)[None, :]).astype(jnp.int32)
    norm_pre = 1.0 + nrm((DEPTH, D_MODEL), 0.02)
    norm_post = 1.0 + nrm((DEPTH, D_MODEL), 0.02)

    nA = N_S5_LAYERS
    s5_w_in = nrm((nA, D_MODEL, 2 * S5_WIDTH), D_MODEL ** -0.5)
    s5_lambda_re = -0.5 + nrm((nA, S5_GROUPS, S5_STATE), 0.01)
    s5_lambda_im = (math.pi * jnp.arange(S5_STATE, dtype=jnp.float32))[None, None, :] + nrm((nA, S5_GROUPS, S5_STATE), 0.01)
    s5_log_dt = jax.random.uniform(next(ks), (nA, S5_GROUPS), jnp.float32, math.log(DT_MIN), math.log(DT_MAX))
    s5_b_re = nrm((nA, S5_GROUPS, S5_STATE, S5_GROUP), (2.0 * S5_GROUP) ** -0.5)
    s5_b_im = nrm((nA, S5_GROUPS, S5_STATE, S5_GROUP), (2.0 * S5_GROUP) ** -0.5)
    s5_c_re = nrm((nA, S5_GROUPS, S5_GROUP, S5_STATE), (2.0 * S5_STATE) ** -0.5)
    s5_c_im = nrm((nA, S5_GROUPS, S5_GROUP, S5_STATE), (2.0 * S5_STATE) ** -0.5)
    s5_d = nrm((nA, S5_WIDTH), 1.0)
    s5_w_glu = nrm((nA, S5_WIDTH, S5_WIDTH), S5_WIDTH ** -0.5)
    s5_b_glu = nrm((nA, S5_WIDTH), 0.02)
    s5_w_out = nrm((nA, S5_WIDTH, D_MODEL), S5_WIDTH ** -0.5)

    nB = N_HG_LAYERS
    hg_w_in = nrm((nB, D_MODEL, 4 * HG_WIDTH), D_MODEL ** -0.5)
    hg_lb_logits = nrm((DEPTH, HG_WIDTH), 0.1)
    hg_norm = 1.0 + nrm((nB, HG_WIDTH), 0.02)
    hg_w_out = nrm((nB, HG_WIDTH, D_MODEL), HG_WIDTH ** -0.5)

    nC = N_AT_LAYERS
    at_w_in = nrm((nC, D_MODEL, AT_QKV_WIDTH + AT_Q_WIDTH), D_MODEL ** -0.5)
    at_b_in = nrm((nC, AT_QKV_WIDTH), 0.02)
    at_sinks = nrm((nC, AT_Q_HEADS), 0.5)
    at_w_out = nrm((nC, AT_Q_WIDTH, D_MODEL), AT_Q_WIDTH ** -0.5)

    return {'x': x, 'positions': positions, 'norm_pre': norm_pre, 'norm_post': norm_post,
            's5_w_in': s5_w_in, 's5_lambda_re': s5_lambda_re, 's5_lambda_im': s5_lambda_im,
            's5_log_dt': s5_log_dt, 's5_b_re': s5_b_re, 's5_b_im': s5_b_im,
            's5_c_re': s5_c_re, 's5_c_im': s5_c_im, 's5_d': s5_d,
            's5_w_glu': s5_w_glu, 's5_b_glu': s5_b_glu, 's5_w_out': s5_w_out,
            'hg_w_in': hg_w_in, 'hg_lb_logits': hg_lb_logits, 'hg_norm': hg_norm, 'hg_w_out': hg_w_out,
            'at_w_in': at_w_in, 'at_b_in': at_b_in, 'at_sinks': at_sinks, 'at_w_out': at_w_out}


def reference(x, positions, norm_pre, norm_post,
              s5_w_in, s5_lambda_re, s5_lambda_im, s5_log_dt, s5_b_re, s5_b_im,
              s5_c_re, s5_c_im, s5_d, s5_w_glu, s5_b_glu, s5_w_out,
              hg_w_in, hg_lb_logits, hg_norm, hg_w_out,
              at_w_in, at_b_in, at_sinks, at_w_out):
    lower_bounds = hgrn2_lower_bounds(hg_lb_logits)
    h = x
    for i in range(DEPTH):
        kind, j = i % N_MIXERS, i // N_MIXERS
        u = rms_norm(h, norm_pre[i])
        if kind == 0:
            y = s5_branch(u, s5_w_in[j], s5_lambda_re[j], s5_lambda_im[j], s5_log_dt[j],
                          s5_b_re[j], s5_b_im[j], s5_c_re[j], s5_c_im[j], s5_d[j],
                          s5_w_glu[j], s5_b_glu[j], s5_w_out[j])
        elif kind == 1:
            y = hgrn2_branch(u, hg_w_in[j], lower_bounds[i], hg_norm[j], hg_w_out[j])
        else:
            y = swa_branch(u, positions, at_w_in[j], at_b_in[j], at_sinks[j], at_w_out[j])
        h = h + rms_norm(y, norm_post[i])
    return h
```

```cpp
#include <hip/hip_runtime.h>
#include <cstdio>
#include <cstdint>

namespace pg8 {
#define PG8_LAS __attribute__((address_space(3)))
typedef unsigned short bf16_t;
typedef short bf16x8 __attribute__((ext_vector_type(8)));
typedef float f32x4 __attribute__((ext_vector_type(4)));
typedef unsigned u32x4 __attribute__((ext_vector_type(4)));
typedef unsigned u32x2 __attribute__((ext_vector_type(2)));
constexpr int BM = 256, BK = 64, HALF = 128, HTB = HALF * BK * 2  , STAGE_BYTES = 8 * HTB, NXCD = 8, WGM = 8;

__host__ __device__ __forceinline__ int lds_byte(int r, int c) { const int st = (r >> 4) * 2 + (c >> 5), rr = r & 15, cc = c & 31, ob = rr * 64 + cc * 2; return st * 1024 + (ob ^ (((ob >> 9) & 1) << 5)); }
__host__ __device__ __forceinline__ void stage_rc(int b, int& R, int& C) { const int st = b / 1024, sb = b % 1024, swz = sb ^ (((sb >> 9) & 1) << 5); R = (st >> 1) * 16 + swz / 64; C = (st & 1) * 32 + (swz % 64) / 2; }
__host__ __device__ __forceinline__ int perm32(int rho) { const int n = rho >> 4, i = rho & 15; return 8 * (i >> 2) + 4 * n + (i & 3); }

struct Unit { int pm, pn; long aoff, boff; };
struct Gemm { const char* A; const char* Bt; };
template <long KSA, long HSA, long KSB, long HSB, int NT> struct Cfg { static constexpr long kstepA = KSA, hstepA = HSA, kstepB = KSB, hstepB = HSB, dA = HSA / 2, dB = (HSB ? HSB / 2 : 64 * 256 * 2); static constexpr int nt = NT; };

__device__ __forceinline__ unsigned cvt_pk_bf16(float lo, float hi) { unsigned r; asm volatile("v_cvt_pk_bf16_f32 %0, %1, %2" : "=v"(r) : "v"(lo), "v"(hi)); return r; }

template <class C, class Epi, class Sched, bool ALIGN_EPI = false, bool SP2 = false>
__device__ __forceinline__ void gemm_phase(PG8_LAS unsigned char* lds, const Gemm g, const unsigned voffA, const unsigned voffB, const Sched& S, const Epi& E) {
    int tid_ = threadIdx.x; asm volatile("" : "+v"(tid_));
    const int tid = tid_, wid = __builtin_amdgcn_readfirstlane(tid >> 6), lane = tid & 63, wr = wid >> 2, wc = wid & 3, fr = lane & 15, fq = lane >> 4;
    constexpr int nt = C::nt;
    constexpr long kstepA = C::kstepA, hstepA = C::hstepA, kstepB = C::kstepB, hstepB = C::hstepB;
    const unsigned ldsw = (unsigned)wid * 1024u;
    const int aoff = lds_byte(wr * 64 + fr, fq * 8), boff = lds_byte(wc * 32 + fr, fq * 8);
#define PG8_SA(b, h) (((b) * 2 + (h)) * HTB)
#define PG8_SB(b, h) ((4 + (b) * 2 + (h)) * HTB)
#define PG8_STAGE(bufoff, gbase, voff) do { _Pragma("unroll") for (int _i = 0; _i < 2; ++_i) \
        __builtin_amdgcn_global_load_lds((const unsigned*)((const char*)(gbase) + (size_t)_i * PG8_D_##voff + (voff)), (PG8_LAS unsigned*)(lds + (bufoff) + ldsw + _i * 8192), 16, 0, 0); } while (0)
#define PG8_D_voffA C::dA
#define PG8_D_voffB C::dB
#define PG8_LDA(dst, b, h) do { _Pragma("unroll") for (int m = 0; m < 4; ++m) _Pragma("unroll") for (int k = 0; k < 2; ++k) dst[m][k] = *(const PG8_LAS bf16x8*)(lds + PG8_SA(b, h) + aoff + m * 2048 + k * 1024); } while (0)
#define PG8_LDB(dst, b, h) do { _Pragma("unroll") for (int n = 0; n < 2; ++n) _Pragma("unroll") for (int k = 0; k < 2; ++k) dst[n][k] = *(const PG8_LAS bf16x8*)(lds + PG8_SB(b, h) + boff + n * 2048 + k * 1024); } while (0)
#define PG8_MMA(ai, bj, At, Bt) do { __builtin_amdgcn_s_setprio(1); _Pragma("unroll") for (int m = 0; m < 4; ++m) _Pragma("unroll") for (int n = 0; n < 2; ++n) _Pragma("unroll") for (int k = 0; k < 2; ++k) \
        acc[ai][bj][m][n] = __builtin_amdgcn_mfma_f32_16x16x32_bf16(Bt[n][k], At[m][k], acc[ai][bj][m][n], 0, 0, 0); __builtin_amdgcn_s_setprio(0); } while (0)
#define PG8_WAIT_V(n) asm volatile("s_waitcnt vmcnt(" #n ")" ::: "memory")
#define PG8_WAIT_L(n) asm volatile("s_waitcnt lgkmcnt(" #n ")" ::: "memory")
#define PG8_BAR __builtin_amdgcn_s_barrier()
#define PG8_SCHED __builtin_amdgcn_sched_barrier(0)
    Unit cur, nxt; int ui = 0;
    if (!S.next(0, cur)) return;
    f32x4 acc[2][2][4][2];
#pragma unroll
    for (int a = 0; a < 2; ++a)
#pragma unroll
        for (int b = 0; b < 2; ++b)
#pragma unroll
            for (int m = 0; m < 4; ++m)
#pragma unroll
                for (int n = 0; n < 2; ++n) acc[a][b][m][n] = (f32x4){0.f, 0.f, 0.f, 0.f};
    bf16x8 At[4][2], B0[2][2], B1[2][2];
    const char* cA = g.A + cur.aoff; const char* cB = g.Bt + cur.boff;
    if constexpr (SP2) {
        PG8_STAGE(PG8_SB(0, 0), cB, voffB); PG8_STAGE(PG8_SB(0, 1), cB + hstepB, voffB); PG8_STAGE(PG8_SA(0, 0), cA, voffA); PG8_STAGE(PG8_SA(0, 1), cA + hstepA, voffA);
        if (wr == 1) PG8_BAR;
        PG8_WAIT_V(2); PG8_BAR;
        PG8_STAGE(PG8_SB(1, 0), cB + kstepB, voffB); PG8_STAGE(PG8_SA(1, 0), cA + kstepA, voffA); PG8_STAGE(PG8_SB(1, 1), cB + hstepB + kstepB, voffB);
        PG8_WAIT_V(6); PG8_BAR;
    } else {
        PG8_STAGE(PG8_SB(0, 0), cB, voffB); PG8_STAGE(PG8_SA(0, 0), cA, voffA); PG8_STAGE(PG8_SB(0, 1), cB + hstepB, voffB); PG8_STAGE(PG8_SA(0, 1), cA + hstepA, voffA);
        if (wr == 1) PG8_BAR;
        PG8_WAIT_V(4); PG8_BAR;
        PG8_STAGE(PG8_SB(1, 0), cB + kstepB, voffB); PG8_STAGE(PG8_SA(1, 0), cA + kstepA, voffA); PG8_STAGE(PG8_SB(1, 1), cB + hstepB + kstepB, voffB);
        PG8_WAIT_V(6); PG8_BAR;
    }
    for (;;) {
        const bool has_next = S.next(ui + 1, nxt);
        const char* nA = has_next ? g.A + nxt.aoff : cA; const char* nB = has_next ? g.Bt + nxt.boff : cB;
        for (int t = 0; t < nt; t += 2) {
            const bool last = (t == nt - 2);
            const char* a1 = cA + (size_t)(t + 1) * kstepA;
            const char* a2 = last ? nA : cA + (size_t)(t + 2) * kstepA; const char* b2 = last ? nB : cB + (size_t)(t + 2) * kstepB;
            const char* a3 = a2 + kstepA; const char* b3 = b2 + kstepB;
            if constexpr (SP2) {
            PG8_LDB(B0, 0, 0); PG8_LDB(B1, 0, 1); PG8_SCHED; PG8_LDA(At, 0, 0); PG8_STAGE(PG8_SA(1, 1), a1 + hstepA, voffA);
            PG8_WAIT_V(8); PG8_WAIT_L(0); PG8_BAR; PG8_MMA(0, 0, At, B0); PG8_MMA(0, 1, At, B1); PG8_BAR; PG8_SCHED;
            PG8_LDA(At, 0, 1); PG8_STAGE(PG8_SB(0, 0), b2, voffB); PG8_STAGE(PG8_SB(0, 1), b2 + hstepB, voffB); PG8_STAGE(PG8_SA(0, 0), a2, voffA);
            PG8_WAIT_V(8); PG8_WAIT_L(0); PG8_BAR; PG8_MMA(1, 0, At, B0); PG8_MMA(1, 1, At, B1); PG8_BAR; PG8_SCHED;
            PG8_LDB(B0, 1, 0); PG8_LDB(B1, 1, 1); PG8_SCHED; PG8_LDA(At, 1, 0); PG8_STAGE(PG8_SA(0, 1), a2 + hstepA, voffA);
            PG8_WAIT_V(8); PG8_WAIT_L(0); PG8_BAR; PG8_MMA(0, 0, At, B0); PG8_MMA(0, 1, At, B1); PG8_BAR; PG8_SCHED;
            PG8_LDA(At, 1, 1); PG8_STAGE(PG8_SB(1, 0), b3, voffB); PG8_STAGE(PG8_SB(1, 1), b3 + hstepB, voffB); PG8_STAGE(PG8_SA(1, 0), a3, voffA);
            PG8_WAIT_V(8); PG8_WAIT_L(0); PG8_BAR; PG8_MMA(1, 0, At, B0); PG8_MMA(1, 1, At, B1); PG8_BAR; PG8_SCHED;
            } else {
            PG8_LDB(B0, 0, 0); PG8_SCHED; PG8_LDA(At, 0, 0); PG8_STAGE(PG8_SA(1, 1), a1 + hstepA, voffA);
            PG8_WAIT_L(8); PG8_BAR; PG8_WAIT_L(0); PG8_MMA(0, 0, At, B0); PG8_BAR; PG8_SCHED;
            PG8_LDB(B1, 0, 1); PG8_STAGE(PG8_SB(0, 0), b2, voffB);
            PG8_BAR; PG8_WAIT_L(0); PG8_MMA(0, 1, At, B1); PG8_BAR;
            PG8_LDA(At, 0, 1); PG8_STAGE(PG8_SA(0, 0), a2, voffA);
            PG8_BAR; PG8_WAIT_L(0); PG8_MMA(1, 0, At, B0); PG8_BAR; PG8_SCHED;
            PG8_STAGE(PG8_SB(0, 1), b2 + hstepB, voffB);
            PG8_WAIT_V(6); PG8_BAR; PG8_MMA(1, 1, At, B1); PG8_BAR;
            PG8_LDB(B0, 1, 0); PG8_SCHED; PG8_LDA(At, 1, 0); PG8_STAGE(PG8_SA(0, 1), a2 + hstepA, voffA);
            PG8_WAIT_L(8); PG8_BAR; PG8_WAIT_L(0); PG8_MMA(0, 0, At, B0); PG8_BAR; PG8_SCHED;
            PG8_LDB(B1, 1, 1); PG8_STAGE(PG8_SB(1, 0), b3, voffB);
            PG8_BAR; PG8_WAIT_L(0); PG8_MMA(0, 1, At, B1); PG8_BAR;
            PG8_LDA(At, 1, 1); PG8_STAGE(PG8_SA(1, 0), a3, voffA);
            PG8_BAR; PG8_WAIT_L(0); PG8_MMA(1, 0, At, B0); PG8_BAR; PG8_SCHED;
            PG8_STAGE(PG8_SB(1, 1), b3 + hstepB, voffB);
            PG8_WAIT_V(6); PG8_BAR; PG8_MMA(1, 1, At, B1); PG8_BAR;
            }
        }
        if constexpr (ALIGN_EPI) { if (wr == 0) PG8_BAR; }
        if constexpr (!Epi::AFTER_DRAIN) { E(acc, cur, wr, wc, fr, fq); }
        if (!has_next) break;
#pragma unroll
        for (int a = 0; a < 2; ++a)
#pragma unroll
            for (int b = 0; b < 2; ++b)
#pragma unroll
                for (int m = 0; m < 4; ++m)
#pragma unroll
                    for (int n = 0; n < 2; ++n) acc[a][b][m][n] = (f32x4){0.f, 0.f, 0.f, 0.f};
        cur = nxt; cA = nA; cB = nB; ++ui;
        if constexpr (ALIGN_EPI) { if (wr == 1) PG8_BAR; }
    }
    PG8_WAIT_V(0);
    if constexpr (!ALIGN_EPI) { if (wr == 0) PG8_BAR; }
    PG8_BAR;
    if constexpr (Epi::AFTER_DRAIN) { E.fused(acc, cur, wr, wc, fr, fq, lds, wid, lane); }
#undef PG8_SA
#undef PG8_SB
#undef PG8_STAGE
#undef PG8_D_voffA
#undef PG8_D_voffB
#undef PG8_LDA
#undef PG8_LDB
#undef PG8_MMA
#undef PG8_WAIT_V
#undef PG8_WAIT_L
#undef PG8_BAR
#undef PG8_SCHED
}
}

constexpr int NWAVES = 8;
constexpr int BATCH = 2, SEQ = 8192, DM = 1024, M = BATCH * SEQ;
constexpr float NORM_EPS = 1e-6f;
constexpr int NPHASES = 24;
#ifndef MK_N_LAUNCHES
#define MK_N_LAUNCHES 1
#endif

constexpr size_t MiB = 1u << 20;
constexpr size_t WS_CTL = 0, CTL_ZERO_BYTES = 1 * MiB;
constexpr size_t WS_MISC = 1 * MiB;
constexpr size_t MISC_LB = 0, MISC_A16 = 65536;
constexpr size_t WS_W_S5IN0 = 2 * MiB, WS_W_S5GLU0 = 6 * MiB, WS_W_S5OUT0 = 8 * MiB, WS_W_S5IN1 = 10 * MiB, WS_W_S5GLU1 = 14 * MiB, WS_W_S5OUT1 = 16 * MiB;
constexpr size_t WS_W_HGIN = 18 * MiB, WS_W_HGOUT = 26 * MiB, WS_W_ATIN = 28 * MiB, WS_W_ATOUT = 33 * MiB;
constexpr size_t WS_TV0 = 36 * MiB, WS_WM0 = 48 * MiB, WS_TV1 = 52 * MiB, WS_WM1 = 64 * MiB;
constexpr size_t WS_ROPE = 68 * MiB;
constexpr size_t WS_ACT = 72 * MiB;
constexpr size_t A_XN = WS_ACT + 0 * MiB;
constexpr size_t A_Y2_S5 = WS_ACT + 0 * MiB;
constexpr size_t A_XCAT = WS_ACT + 32 * MiB;
constexpr size_t A_SZ_S5 = WS_ACT + 80 * MiB;
constexpr size_t A_DS = WS_ACT + 112 * MiB;
constexpr size_t A_YG = WS_ACT + 144 * MiB;
constexpr size_t A_OUT_S5 = WS_ACT + 32 * MiB;
constexpr size_t A_O_HG = WS_ACT + 0 * MiB;
constexpr size_t A_Q_HG = WS_ACT + 32 * MiB, A_Y2_HG = WS_ACT + 32 * MiB, A_F_HG = WS_ACT + 64 * MiB, A_V_HG = WS_ACT + 96 * MiB, A_SZ_HG = WS_ACT + 128 * MiB, A_OUT_HG = WS_ACT + 64 * MiB;
constexpr size_t A_Q_AT = WS_ACT + 32 * MiB, A_K_AT = WS_ACT + 64 * MiB, A_V_AT = WS_ACT + 72 * MiB, A_SZ_AT = WS_ACT + 80 * MiB, A_Y2_AT = WS_ACT + 112 * MiB, A_OUT_AT = WS_ACT + 32 * MiB;
constexpr size_t WS_END = 256 * MiB;
constexpr int CW_BAR = 4096;

constexpr int RING_OFF = 0, RING_BYTES = 131072;
constexpr int LDSCTL_OFF = RING_BYTES, MISC_OFF = LDSCTL_OFF + 320;
constexpr int LDS_BYTES = 147456;

#define GAS __attribute__((address_space(1)))
#define LAS __attribute__((address_space(3)))
typedef unsigned short bf16;
typedef unsigned v4u __attribute__((ext_vector_type(4)));
typedef unsigned v2u __attribute__((ext_vector_type(2)));
typedef float f32x4 __attribute__((ext_vector_type(4)));
#define LDS_WAIT() asm volatile("s_waitcnt lgkmcnt(0)" ::: "memory")
#define VM_WAIT() asm volatile("s_waitcnt vmcnt(0)" ::: "memory")
__device__ __forceinline__ unsigned f2bf(float f) { unsigned u = __builtin_bit_cast(unsigned, f); return (u + 0x7fffu + ((u >> 16) & 1u)) >> 16; }
__device__ __forceinline__ unsigned pk2(float lo, float hi) { return f2bf(lo) | (f2bf(hi) << 16); }
__device__ __forceinline__ float bf_lo(unsigned w) { return __builtin_bit_cast(float, w << 16); }
__device__ __forceinline__ float bf_hi(unsigned w) { return __builtin_bit_cast(float, w & 0xffff0000u); }
__device__ __forceinline__ float bf2f(bf16 h) { return __builtin_bit_cast(float, (unsigned)h << 16); }
__device__ __forceinline__ float sigmoid_f(float x) { return 1.f / (1.f + __expf(-x)); }
__device__ __forceinline__ float silu_f(float x) { return x / (1.f + __expf(-x)); }
__device__ __forceinline__ float gelu_tanh_f(float x) { const float u = 0.7978845608028654f * (x + 0.044715f * x * x * x); const float e = __expf(2.f * u); return 0.5f * x * (2.f - 2.f / (1.f + e)); }
template <int PAT> __device__ __forceinline__ float swz_f(float v) { return __builtin_bit_cast(float, __builtin_amdgcn_ds_swizzle(__builtin_bit_cast(int, v), PAT)); }
__device__ __forceinline__ float xor_sum_1(float v)  { return v + swz_f<0x041f>(v); }
__device__ __forceinline__ float xor_sum_2(float v)  { return v + swz_f<0x081f>(v); }
__device__ __forceinline__ float xor_sum_4(float v)  { return v + swz_f<0x101f>(v); }
__device__ __forceinline__ float xor_sum_8(float v)  { return v + swz_f<0x201f>(v); }
__device__ __forceinline__ float xor_sum_16(float v) { return v + swz_f<0x401f>(v); }
__device__ __forceinline__ float xor_sum_32(float v) { const unsigned u = __builtin_bit_cast(unsigned, v); auto r = __builtin_amdgcn_permlane32_swap(u, u, false, false); return __builtin_bit_cast(float, (unsigned)r[0]) + __builtin_bit_cast(float, (unsigned)r[1]); }
__device__ __forceinline__ float wave_sum(float v) { return xor_sum_32(xor_sum_16(xor_sum_8(xor_sum_4(xor_sum_2(xor_sum_1(v)))))); }

#define XB_TMO      128
#define XB_XCNT(j)  (256  + 64 * (j))
#define XB_XSUB(j)  (1280 + 64 * (j))
#define XB_XGEN(j)  (2304 + 64 * (j))
#define XB_TOP      3328
#define XB_TOPGEN   3392
#define XCD_BAR_WORDS 3456
#define XB_SPIN_CAP (1u << 18)
__device__ __forceinline__ unsigned xb_ld(unsigned* p)              { return __hip_atomic_load(p, __ATOMIC_RELAXED, __HIP_MEMORY_SCOPE_AGENT); }
__device__ __forceinline__ unsigned xb_add(unsigned* p, unsigned v) { return __hip_atomic_fetch_add(p, v, __ATOMIC_RELAXED, __HIP_MEMORY_SCOPE_AGENT); }
__device__ __forceinline__ unsigned xb_xcc_id() { return (unsigned)__builtin_amdgcn_s_getreg((3 << 11) | 20) & 0xFu; }
#define XB_SPIN(cond, bar) do { unsigned _sp = 0; while (cond) { __builtin_amdgcn_s_sleep(1); \
    if ((++_sp & 255u) == 0u) { if (xb_ld(&(bar)[XB_TMO])) break; if (_sp > XB_SPIN_CAP) { atomicAdd(&(bar)[XB_TMO], 1u); break; } } } } while (0)
struct XcdBarrier { unsigned* bar; unsigned x; volatile LAS unsigned* st; };
__device__ __forceinline__ XcdBarrier xcd_barrier_post(unsigned* bar, volatile LAS unsigned* st) {
    XcdBarrier b; b.bar = bar; b.x = xb_xcc_id(); b.st = st;
    if (threadIdx.x == 0) (void)xb_add(&bar[XB_XCNT(b.x)], 1u);
    return b;
}
__device__ __forceinline__ void xcd_barrier_complete(unsigned* bar, unsigned x, unsigned& nloc, unsigned& nx) {
    const unsigned G = gridDim.x * gridDim.y * gridDim.z;
    unsigned sum, cnt, mine, sp = 0u;
    for (;;) {
        sum = 0u; cnt = 0u; mine = 0u;
#pragma unroll 1
        for (unsigned j = 0; j < 16; ++j) { const unsigned c = xb_ld(&bar[XB_XCNT(j)]); sum += c; cnt += (c > 0u) ? 1u : 0u; mine = (j == x) ? c : mine; }
        if (sum == G) break;
        __builtin_amdgcn_s_sleep(1);
        if ((++sp & 255u) == 0u) { if (xb_ld(&bar[XB_TMO])) break; if (sp > XB_SPIN_CAP) { atomicAdd(&bar[XB_TMO], 1u); break; } }
    }
    nloc = mine > 0u ? mine : 1u; nx = cnt > 0u ? cnt : 1u;
}
__device__ __forceinline__ void xcd_barrier(const XcdBarrier& b) {
    asm volatile("s_waitcnt vmcnt(0)" ::: "memory");
    __syncthreads();
    if (threadIdx.x == 0) {
        unsigned* bar = b.bar; asm volatile("" : "+s"(bar));
        __builtin_amdgcn_s_waitcnt(0);
        unsigned nloc = b.st[0], nx = b.st[1];
        if (nloc == 0u) { xcd_barrier_complete(bar, b.x, nloc, nx); b.st[0] = nloc; b.st[1] = nx; }
        const unsigned old = xb_add(&bar[XB_XSUB(b.x)], 1u);
        const unsigned gen = old / nloc;
        if (old + 1u == (gen + 1u) * nloc) {
            __builtin_amdgcn_fence(__ATOMIC_RELEASE, "agent");
            asm volatile("s_waitcnt vmcnt(0)" ::: "memory");
            const unsigned og = xb_add(&bar[XB_TOP], 1u);
            const unsigned tg = og / nx;
            if (og + 1u == (tg + 1u) * nx) xb_add(&bar[XB_TOPGEN], 1u);
            else XB_SPIN(xb_ld(&bar[XB_TOPGEN]) == tg, bar);
            __builtin_amdgcn_fence(__ATOMIC_ACQUIRE, "agent");
            xb_add(&bar[XB_XGEN(b.x)], 1u);
            asm volatile("s_waitcnt vmcnt(0)" ::: "memory");
        } else {
            XB_SPIN(xb_ld(&bar[XB_XGEN(b.x)]) == gen, bar);
            __builtin_amdgcn_fence(__ATOMIC_ACQUIRE, "agent");
            asm volatile("s_waitcnt vmcnt(0)" ::: "memory");
        }
    }
    __syncthreads();
}

struct StdOrder {
    int nM, nN, nwg, G, c; long a_tstep, b_tstep;
    __device__ void init(int Mr, int N, int G_, int c_, long at, long bt) { nM = Mr / 256; nN = N / 256; nwg = nM * nN; G = G_; c = c_; a_tstep = at; b_tstep = bt; }
    __device__ bool next(int i, pg8::Unit& u) const {
        const long L = (long)i * G + c; if (L >= nwg) return false;
        int wgid = (int)L; { const int q = nwg / pg8::NXCD, r = nwg % pg8::NXCD, xcd = wgid % pg8::NXCD, off = wgid / pg8::NXCD; wgid = (xcd < r ? xcd * (q + 1) : r * (q + 1) + (xcd - r) * q) + off; }
        const int nig = pg8::WGM * nN, gid = wgid / nig, fm = gid * pg8::WGM, gsz = (nM - fm) < pg8::WGM ? (nM - fm) : pg8::WGM;
        u.pm = fm + ((wgid % nig) % gsz); u.pn = (wgid % nig) / gsz; u.aoff = (long)u.pm * a_tstep; u.boff = (long)u.pn * b_tstep; return true;
    }
};
struct GroupOrder {
    int G, vcu; long a_gstep, a_tstep, b_gstep;
    __device__ bool next(int i, pg8::Unit& u) const {
        const int L = i * G + vcu; if (L >= 256) return false;
        u.pn = L >> 2; u.pm = L & 3; u.aoff = (long)u.pn * a_gstep + (long)u.pm * a_tstep; u.boff = (long)u.pn * b_gstep; return true;
    }
};

using pg8::f32x4; using pg8::Unit;
__device__ __forceinline__ v4u pack8(const f32x4& a, const f32x4& b) { v4u w; w.x = pg8::cvt_pk_bf16(a[0], a[1]); w.y = pg8::cvt_pk_bf16(a[2], a[3]); w.z = pg8::cvt_pk_bf16(b[0], b[1]); w.w = pg8::cvt_pk_bf16(b[2], b[3]); return w; }
__device__ __forceinline__ v2u pack4(const f32x4& a) { v2u w; w.x = pg8::cvt_pk_bf16(a[0], a[1]); w.y = pg8::cvt_pk_bf16(a[2], a[3]); return w; }

struct EpiS5In {
    static constexpr bool PERM = true, AFTER_DRAIN = false;
    bf16* Xcat; bf16* SZ;
    __device__ __forceinline__ void operator()(const f32x4 (&acc)[2][2][4][2], const Unit& u, int wr, int wc, int fr, int fq) const {
        const int row0 = u.pm * 256 + wr * 64 + fr;
#pragma unroll
        for (int ai = 0; ai < 2; ++ai)
#pragma unroll
            for (int m = 0; m < 4; ++m) { const int row = row0 + ai * 128 + m * 16;
#pragma unroll
                for (int bj = 0; bj < 2; ++bj) { const int col8 = u.pn * 256 + bj * 128 + wc * 32 + 8 * fq;
                    f32x4 v0 = acc[ai][bj][m][0], v1 = acc[ai][bj][m][1];
                    if (u.pn < 4) { const int g = col8 >> 4, h0 = col8 & 15;
                        *(v4u*)(Xcat + ((size_t)(g * 1024 + (row >> 4)) * 384 + (row & 15) * 16 + h0)) = pack8(v0, v1);
                    } else {
#pragma unroll
                        for (int e = 0; e < 4; ++e) { v0[e] = silu_f(v0[e]); v1[e] = silu_f(v1[e]); }
                        *(v4u*)(SZ + (size_t)row * 1024 + (col8 - 1024)) = pack8(v0, v1); } } }
    }
};
struct EpiDS {
    static constexpr bool PERM = false, AFTER_DRAIN = false;
    float* DS;
    __device__ __forceinline__ void operator()(const f32x4 (&acc)[2][2][4][2], const Unit& u, int wr, int wc, int fr, int fq) const {
        const int row0 = u.pm * 256 + wr * 64 + fr, col0 = wc * 32 + 4 * fq;
#pragma unroll
        for (int ai = 0; ai < 2; ++ai)
#pragma unroll
            for (int m = 0; m < 4; ++m) { float* rp = DS + ((size_t)u.pn * 1024 + row0 + ai * 128 + m * 16) * 128 + col0;
#pragma unroll
                for (int n = 0; n < 2; ++n) *(f32x4*)(rp + n * 16) = acc[ai][0][m][n]; }
    }
};
struct EpiS3 {
    static constexpr bool PERM = true, AFTER_DRAIN = false;
    bf16* Yg;
    __device__ __forceinline__ void operator()(const f32x4 (&acc)[2][2][4][2], const Unit& u, int wr, int wc, int fr, int fq) const {
        const int row0 = u.pm * 256 + wr * 64 + fr, col0 = wc * 32 + 8 * fq;
#pragma unroll
        for (int ai = 0; ai < 2; ++ai)
#pragma unroll
            for (int m = 0; m < 4; ++m) { bf16* rp = Yg + ((size_t)u.pn * 1024 + row0 + ai * 128 + m * 16) * 256 + col0;
#pragma unroll
                for (int bj = 0; bj < 2; ++bj) { f32x4 v0 = acc[ai][bj][m][0], v1 = acc[ai][bj][m][1];
#pragma unroll
                    for (int e = 0; e < 4; ++e) { v0[e] = gelu_tanh_f(v0[e]); v1[e] = gelu_tanh_f(v1[e]); }
                    *(v4u*)(rp + bj * 128) = pack8(v0, v1); } }
    }
};
struct EpiGlu {
    static constexpr bool PERM = true, AFTER_DRAIN = false;
    const bf16* Yg; const bf16* SZ; const float* bglu; bf16* Y2;
    __device__ __forceinline__ void operator()(const f32x4 (&acc)[2][2][4][2], const Unit& u, int wr, int wc, int fr, int fq) const {
        const int row0 = u.pm * 256 + wr * 64 + fr;
#pragma unroll
        for (int bj = 0; bj < 2; ++bj) { const int col8 = u.pn * 256 + bj * 128 + wc * 32 + 8 * fq;
            const f32x4 b0 = *(const f32x4*)(bglu + col8), b1 = *(const f32x4*)(bglu + col8 + 4);
#pragma unroll
            for (int ai = 0; ai < 2; ++ai)
#pragma unroll
                for (int m = 0; m < 4; ++m) { const int row = row0 + ai * 128 + m * 16;
                    const v4u yw = *(const v4u*)(Yg + ((size_t)(col8 >> 4) * M + row) * 16 + (col8 & 15));
                    const v4u zw = *(const v4u*)(SZ + (size_t)row * 1024 + col8);
                    f32x4 v0 = acc[ai][bj][m][0] + b0, v1 = acc[ai][bj][m][1] + b1;
                    v0[0] = bf_lo(yw.x) * sigmoid_f(v0[0]) * bf_lo(zw.x); v0[1] = bf_hi(yw.x) * sigmoid_f(v0[1]) * bf_hi(zw.x);
                    v0[2] = bf_lo(yw.y) * sigmoid_f(v0[2]) * bf_lo(zw.y); v0[3] = bf_hi(yw.y) * sigmoid_f(v0[3]) * bf_hi(zw.y);
                    v1[0] = bf_lo(yw.z) * sigmoid_f(v1[0]) * bf_lo(zw.z); v1[1] = bf_hi(yw.z) * sigmoid_f(v1[1]) * bf_hi(zw.z);
                    v1[2] = bf_lo(yw.w) * sigmoid_f(v1[2]) * bf_lo(zw.w); v1[3] = bf_hi(yw.w) * sigmoid_f(v1[3]) * bf_hi(zw.w);
                    *(v4u*)(Y2 + (size_t)row * 1024 + col8) = pack8(v0, v1); } }
    }
};
struct EpiF32 {
    static constexpr bool PERM = false, AFTER_DRAIN = false;
    float* C;
    __device__ __forceinline__ void operator()(const f32x4 (&acc)[2][2][4][2], const Unit& u, int wr, int wc, int fr, int fq) const {
        const int row0 = u.pm * 256 + wr * 64 + fr, col0 = u.pn * 256 + wc * 32 + 4 * fq;
#pragma unroll
        for (int ai = 0; ai < 2; ++ai)
#pragma unroll
            for (int m = 0; m < 4; ++m) { float* rowp = C + (size_t)(row0 + ai * 128 + m * 16) * 1024 + col0;
#pragma unroll
                for (int bj = 0; bj < 2; ++bj)
#pragma unroll
                    for (int n = 0; n < 2; ++n) *(f32x4*)(rowp + bj * 128 + n * 16) = acc[ai][bj][m][n]; }
    }
};
struct EpiHgIn {
    static constexpr bool PERM = false, AFTER_DRAIN = false;
    const float* lb; bf16* Q; _Float16* F; bf16* V; bf16* SZ;
    __device__ __forceinline__ void operator()(const f32x4 (&acc)[2][2][4][2], const Unit& u, int wr, int wc, int fr, int fq) const {
        const int row0 = u.pm * 256 + wr * 64 + fr, ch = u.pn * 64 + wc * 16 + 4 * fq;
        const f32x4 lbv = *(const f32x4*)(lb + ch);
#pragma unroll
        for (int ai = 0; ai < 2; ++ai)
#pragma unroll
            for (int m = 0; m < 4; ++m) { const size_t off = (size_t)(row0 + ai * 128 + m * 16) * 1024 + ch;
                const f32x4 q = acc[ai][0][m][0], fz = acc[ai][0][m][1], iv = acc[ai][1][m][0]; f32x4 z = acc[ai][1][m][1];
                typedef _Float16 h4 __attribute__((ext_vector_type(4))); h4 fh;
#pragma unroll
                for (int e = 0; e < 4; ++e) { fh[e] = (_Float16)(lbv[e] + (1.f - lbv[e]) * sigmoid_f(fz[e])); z[e] = silu_f(z[e]); }
                *(v2u*)(Q + off) = pack4(q); *(h4*)(F + off) = fh; *(v2u*)(V + off) = pack4(iv); *(v2u*)(SZ + off) = pack4(z); }
    }
};
struct EpiAtIn {
    static constexpr bool PERM = false, AFTER_DRAIN = false;
    const float* bias; const float* cosT; const float* sinT; bf16* Q; bf16* Kk; bf16* V; bf16* SZ;
    __device__ __forceinline__ void operator()(const f32x4 (&acc)[2][2][4][2], const Unit& u, int wr, int wc, int fr, int fq) const {
        const int row0 = u.pm * 256 + wr * 64 + fr;
        if (u.pn <= 4) {
            const int hb = (u.pn < 4) ? (u.pn * 4 + wc) * 64 : 1024 + wc * 64;
            bf16* dst = (u.pn < 4) ? Q : Kk; const int ld = (u.pn < 4) ? 1024 : 256; const int cb = (u.pn < 4) ? u.pn * 256 : 0;
#pragma unroll
            for (int bj = 0; bj < 2; ++bj) { const int d1 = 16 * bj + 4 * fq;
                const f32x4 bia = *(const f32x4*)(bias + hb + d1), bib = *(const f32x4*)(bias + hb + d1 + 32);
#pragma unroll
                for (int ai = 0; ai < 2; ++ai)
#pragma unroll
                    for (int m = 0; m < 4; ++m) { const int row = row0 + ai * 128 + m * 16;
                        const f32x4 cs = *(const f32x4*)(cosT + (size_t)row * 32 + d1), sn = *(const f32x4*)(sinT + (size_t)row * 32 + d1);
                        const f32x4 t1 = acc[ai][bj][m][0] + bia, t2 = acc[ai][bj][m][1] + bib;
                        const f32x4 o1 = t1 * cs - t2 * sn, o2 = t2 * cs + t1 * sn;
                        bf16* rp = dst + (size_t)row * ld + cb + bj * 128 + wc * 32 + 4 * fq;
                        *(v2u*)(rp) = pack4(o1); *(v2u*)(rp + 16) = pack4(o2); } }
        } else {
#pragma unroll
            for (int bj = 0; bj < 2; ++bj)
#pragma unroll
                for (int n = 0; n < 2; ++n) { const int c = bj * 128 + wc * 32 + n * 16 + 4 * fq;
                    f32x4 bv = (f32x4){0.f, 0.f, 0.f, 0.f}; if (u.pn == 5) bv = *(const f32x4*)(bias + 1280 + c);
#pragma unroll
                    for (int ai = 0; ai < 2; ++ai)
#pragma unroll
                        for (int m = 0; m < 4; ++m) { const int row = row0 + ai * 128 + m * 16; f32x4 v = acc[ai][bj][m][n] + bv;
                            if (u.pn == 5) { *(v2u*)(V + (size_t)row * 256 + c) = pack4(v); }
                            else {
#pragma unroll
                                for (int e = 0; e < 4; ++e) v[e] = silu_f(v[e]);
                                *(v2u*)(SZ + (size_t)row * 1024 + (u.pn - 6) * 256 + c) = pack4(v); } } }
        }
    }
};

__device__ __forceinline__ int src_col(int mapkind, int n) {
    if (mapkind == 0) return n;
    const int pn = n >> 8, c = n & 255;
    if (mapkind == 1) { const int type = 2 * (c >> 7) + ((c >> 4) & 1), ch = 64 * pn + 16 * ((c >> 5) & 3) + (c & 15); return type * 1024 + ch; }
    const int d = 32 * ((c >> 4) & 1) + 16 * (c >> 7) + (c & 15), hl = (c >> 5) & 3;
    if (pn < 4) return (pn * 4 + hl) * 64 + d;
    if (pn == 4) return 1024 + hl * 64 + d;
    if (pn == 5) return 1280 + c;
    return 1536 + (pn - 6) * 256 + c;
}
__device__ __forceinline__ void transpose_item(const float* W, int K, int N, bf16* WT, int mapkind, LAS float* scr, int item, int lane) {
    const int nblk = N / 32, kb = item / nblk, nb = item % nblk, k0 = 64 * kb, n0 = 32 * nb;
    const int sc = src_col(mapkind, n0 + (lane & 31));
#pragma unroll 8
    for (int i = 0; i < 32; ++i) { const int kk = 2 * i + (lane >> 5); scr[kk * 33 + (lane & 31)] = W[(size_t)(k0 + kk) * N + sc]; }
    LDS_WAIT(); asm volatile("" ::: "memory");
    const int c = lane & 7;
#pragma unroll
    for (int j = 0; j < 4; ++j) { const int n = (lane >> 3) + 8 * j; const LAS float* s = scr + (8 * c) * 33 + n;
        v4u o; o.x = pk2(s[0 * 33], s[1 * 33]); o.y = pk2(s[2 * 33], s[3 * 33]); o.z = pk2(s[4 * 33], s[5 * 33]); o.w = pk2(s[6 * 33], s[7 * 33]);
        *(GAS v4u*)(WT + (size_t)(n0 + n) * K + k0 + 8 * c) = o; }
    LDS_WAIT(); asm volatile("" ::: "memory");
}
__device__ __forceinline__ void rms_row_to_bf16(const float* xrow, const float* g, bf16* orow, int lane) {
    const f32x4* xr = (const f32x4*)xrow + lane; const f32x4* gr = (const f32x4*)g + lane;
    f32x4 v[4]; float s = 0.f;
#pragma unroll
    for (int j = 0; j < 4; ++j) { v[j] = xr[64 * j]; s += (v[j].x * v[j].x + v[j].y * v[j].y) + (v[j].z * v[j].z + v[j].w * v[j].w); }
    const float rs = 1.f / sqrtf(wave_sum(s) * (1.f / 1024.f) + NORM_EPS);
    v2u* o8 = (v2u*)orow + lane;
#pragma unroll
    for (int j = 0; j < 4; ++j) { const f32x4 gg = gr[64 * j]; v2u w; w.x = pk2(v[j].x * rs * gg.x, v[j].y * rs * gg.y); w.y = pk2(v[j].z * rs * gg.z, v[j].w * rs * gg.w); o8[64 * j] = w; }
}
__device__ __forceinline__ void s5_build(int jg, const float* lam_re, const float* lam_im, const float* log_dt, const float* b_re, const float* b_im, const float* c_re, const float* c_im,
                                         const float* dskip, bf16* TV, bf16* WM, float* A16, LAS unsigned char* lds, int tid) {
    LAS float* PWr = (LAS float*)lds; LAS float* PWi = PWr + 17 * 64; LAS float* BBr = PWi + 17 * 64; LAS float* BBi = BBr + 1024; LAS float* CCr = BBi + 1024; LAS float* CCi = CCr + 1024; LAS float* KK = CCi + 1024;
    if (tid < 64) { const int p = tid; const float lr = lam_re[jg * 64 + p], li = lam_im[jg * 64 + p], dt = expf(log_dt[jg]);
        const float mag = expf(lr * dt), ar = mag * cosf(li * dt), ai = mag * sinf(li * dt), den = lr * lr + li * li;
        const float qr = ((ar - 1.f) * lr + ai * li) / den, qi = (ai * lr - (ar - 1.f) * li) / den;
        for (int h = 0; h < 16; ++h) { const float br = b_re[(jg * 64 + p) * 16 + h], bi = b_im[(jg * 64 + p) * 16 + h]; BBr[p * 16 + h] = qr * br - qi * bi; BBi[p * 16 + h] = qr * bi + qi * br; }
        float pr = 1.f, pi = 0.f;
        for (int k = 0; k <= 16; ++k) { PWr[k * 64 + p] = pr; PWi[k * 64 + p] = pi; const float nr = pr * ar - pi * ai, ni = pr * ai + pi * ar; pr = nr; pi = ni; }
        A16[(jg * 64 + p) * 2 + 0] = PWr[16 * 64 + p]; A16[(jg * 64 + p) * 2 + 1] = PWi[16 * 64 + p]; }
    for (int e = tid; e < 1024; e += 512) { CCr[e] = c_re[jg * 1024 + e]; CCi[e] = c_im[jg * 1024 + e]; }
    __syncthreads();
    for (int e = tid; e < 4096; e += 512) { const int k = e >> 8, ho = (e >> 4) & 15, hi = e & 15; float s = 0.f;
        for (int p = 0; p < 64; ++p) { const float cr = CCr[ho * 64 + p], ci = CCi[ho * 64 + p], wr_ = PWr[k * 64 + p], wi_ = PWi[k * 64 + p];
            const float xr = cr * wr_ - ci * wi_, xi = cr * wi_ + ci * wr_; s += xr * BBr[p * 16 + hi] - xi * BBi[p * 16 + hi]; }
        if (k == 0 && ho == hi) s += dskip[(jg >> 6) * 1024 + (jg & 63) * 16 + ho];
        KK[e] = s; }
    __syncthreads();
    const int g = jg & 63;
    bf16* tv = TV + (size_t)g * 256 * 384;
    for (int e = tid; e < 256 * 384; e += 512) { const int n = e / 384, kk = e - n * 384, jj = n >> 4, ho = n & 15; float val;
        if (kk < 256) { const int i = kk >> 4, hi = kk & 15; val = (i <= jj) ? KK[(jj - i) * 256 + ho * 16 + hi] : 0.f; }
        else if (kk < 320) { const int p = kk - 256; val = CCr[ho * 64 + p] * PWr[(jj + 1) * 64 + p] - CCi[ho * 64 + p] * PWi[(jj + 1) * 64 + p]; }
        else { const int p = kk - 320; val = -(CCr[ho * 64 + p] * PWi[(jj + 1) * 64 + p] + CCi[ho * 64 + p] * PWr[(jj + 1) * 64 + p]); }
        tv[e] = (bf16)f2bf(val); }
    bf16* wm = WM + (size_t)g * 128 * 256;
    for (int e = tid; e < 128 * 256; e += 512) { const int n = e >> 8, kk = e & 255, i = kk >> 4, hi = kk & 15, p = n & 63, pw = 15 - i;
        const float re = PWr[pw * 64 + p] * BBr[p * 16 + hi] - PWi[pw * 64 + p] * BBi[p * 16 + hi], im = PWr[pw * 64 + p] * BBi[p * 16 + hi] + PWi[pw * 64 + p] * BBr[p * 16 + hi];
        wm[e] = (bf16)f2bf(n < 64 ? re : im); }
    __syncthreads();
}

struct Args { const void* in[24]; float* out; unsigned char* ws; int ph_lo, ph_hi; };
constexpr int PT_OFF = LDSCTL_OFF + 1024;
enum { I_X = 0, I_POS, I_NPRE, I_NPOST, I_S5WIN, I_S5LRE, I_S5LIM, I_S5LDT, I_S5BRE, I_S5BIM, I_S5CRE, I_S5CIM, I_S5D, I_S5WGLU, I_S5BGLU, I_S5WOUT, I_HGWIN, I_HGLBL, I_HGNORM, I_HGWOUT, I_ATWIN, I_ATBIN, I_ATSINK, I_ATWOUT, I_OUT, I_WS };
__device__ __forceinline__ unsigned char* gptr(LAS unsigned char* lds, int k) {
    unsigned off = PT_OFF + 8 * k; asm volatile("" : "+v"(off));
    const volatile LAS unsigned* t = (const volatile LAS unsigned*)(lds + off);
    const unsigned lo = __builtin_amdgcn_readfirstlane(t[0]), hi = __builtin_amdgcn_readfirstlane(t[1]);
    return (unsigned char*)(((unsigned long long)hi << 32) | lo);
}
#define VOFF_ROWMAJOR(v, ld, perm) do { int tq_ = threadIdx.x; asm volatile("" : "+v"(tq_)); int R_, C_; pg8::stage_rc(tq_ * 16, R_, C_); if (perm) R_ = (R_ & ~31) + pg8::perm32(R_ & 31); (v) = (unsigned)(R_ * (ld) + C_) * 2u; } while (0)

__global__ void __launch_bounds__(NWAVES * 64, 2) mk_fwd(Args args) {
    extern __shared__ __attribute__((aligned(16))) unsigned char lds_raw[];
    LAS unsigned char* lds = (LAS unsigned char*)lds_raw;
    volatile LAS unsigned* MISC = (volatile LAS unsigned*)(lds + MISC_OFF);
    for (int u = threadIdx.x; u < (LDS_BYTES - LDSCTL_OFF) / 4; u += NWAVES * 64) ((LAS unsigned*)(lds + LDSCTL_OFF))[u] = 0u;
    __syncthreads();
    if (threadIdx.x == 0) { volatile LAS unsigned long long* t = (volatile LAS unsigned long long*)(lds + PT_OFF);
#pragma unroll
        for (int k = 0; k < 24; ++k) t[k] = (unsigned long long)args.in[k];
        t[I_OUT] = (unsigned long long)args.out; t[I_WS] = (unsigned long long)args.ws; }
    __syncthreads();
    const int lo = args.ph_lo, hi = args.ph_hi;
    XcdBarrier bar = xcd_barrier_post((unsigned*)(gptr(lds, I_WS) + WS_CTL) + CW_BAR, MISC + 8);
    enum { OP_PRO = 0, OP_S5IN, OP_S1, OP_S2, OP_S3, OP_GLU, OP_HGIN, OP_HGREC, OP_HGNORM, OP_ATIN, OP_ATT, OP_OUT, OP_NORM };
#define TID ({ int t_ = threadIdx.x; asm volatile("" : "+v"(t_)); t_; })
#define LANE (TID & 63)
#define WAVE (__builtin_amdgcn_readfirstlane(TID >> 6))
#define GRID ({ int g_ = gridDim.x; asm volatile("" : "+s"(g_)); g_; })
#define BX ({ int b_ = blockIdx.x; asm volatile("" : "+s"(b_)); b_; })
#define VCU ((GRID % 8 == 0) ? (BX % 8) * (GRID / 8) + BX / 8 : BX)
#define GW (VCU * NWAVES + WAVE)
#define NGW (GRID * NWAVES)

#pragma unroll 1
    for (int ph = lo; ph < hi; ++ph) {
    int layer, sub;
    if (ph < 8) { layer = 0; sub = ph - 1; } else if (ph < 13) { layer = 1; sub = ph - 8; } else if (ph < 17) { layer = 2; sub = ph - 13; } else { layer = 3; sub = ph - 17; }
    const int kind = layer % 3, jj = layer / 3;
    int op;
    if (ph == 0) op = OP_PRO;
    else if (kind == 0) op = (sub < 5) ? OP_S5IN + sub : (sub == 5 ? OP_OUT : OP_NORM);
    else if (kind == 1) op = (sub < 3) ? OP_HGIN + sub : (sub == 3 ? OP_OUT : OP_NORM);
    else op = (sub < 2) ? OP_ATIN + sub : (sub == 2 ? OP_OUT : OP_NORM);
    if (op == OP_PRO) {
        unsigned char* ws = gptr(lds, I_WS);
        const int lane = LANE, wave = WAVE, gw = GW, ngw = NGW;
        LAS float* scr = (LAS float*)(lds + RING_OFF + wave * 16384);
        int base = 0;
#define DO_W(idx_, soff_, K_, N_, dst_, map_) do { const float* Wp_ = (const float*)gptr(lds, idx_) + (size_t)(soff_); const int nit = ((K_) / 64) * ((N_) / 32); int first = gw - (base % ngw); if (first < 0) first += ngw; \
            for (int it = first; it < nit; it += ngw) transpose_item(Wp_, (K_), (N_), (bf16*)(ws + (dst_)), (map_), scr, it, lane); base += nit; } while (0)
        DO_W(I_S5WIN, 0, 1024, 2048, WS_W_S5IN0, 0); DO_W(I_S5WIN, 1024 * 2048, 1024, 2048, WS_W_S5IN1, 0);
        DO_W(I_S5WGLU, 0, 1024, 1024, WS_W_S5GLU0, 0); DO_W(I_S5WGLU, 1024 * 1024, 1024, 1024, WS_W_S5GLU1, 0);
        DO_W(I_S5WOUT, 0, 1024, 1024, WS_W_S5OUT0, 0); DO_W(I_S5WOUT, 1024 * 1024, 1024, 1024, WS_W_S5OUT1, 0);
        DO_W(I_HGWIN, 0, 1024, 4096, WS_W_HGIN, 1); DO_W(I_HGWOUT, 0, 1024, 1024, WS_W_HGOUT, 0);
        DO_W(I_ATWIN, 0, 1024, 2560, WS_W_ATIN, 2); DO_W(I_ATWOUT, 0, 1024, 1024, WS_W_ATOUT, 0);
#undef DO_W
        { const float* x = (const float*)gptr(lds, I_X); const float* npre = (const float*)gptr(lds, I_NPRE); bf16* XN = (bf16*)(ws + A_XN);
          for (int m = gw; m < M; m += ngw) rms_row_to_bf16(x + (size_t)m * DM, npre, XN + (size_t)m * DM, lane); }
        { const int* positions = (const int*)gptr(lds, I_POS); float* cosT = (float*)(ws + WS_ROPE); float* sinT = cosT + (size_t)M * 32;
          for (int e = BX * 512 + TID; e < M * 32; e += GRID * 512) { const int r = e >> 5, i = e & 31;
            const float inv = powf(10000.f, -(float)(2 * i) / 64.f); const float ang = (float)positions[r] * inv; cosT[e] = cosf(ang); sinT[e] = sinf(ang); } }
        { const float* hg_lbl = (const float*)gptr(lds, I_HGLBL); float* lbv = (float*)(ws + WS_MISC + MISC_LB);
          for (int c = BX * 512 + TID; c < 1024; c += GRID * 512) { const float l0 = hg_lbl[c], l1 = hg_lbl[1024 + c], l2 = hg_lbl[2048 + c], l3 = hg_lbl[3072 + c];
            const float mx = fmaxf(fmaxf(l0, l1), fmaxf(l2, l3)); const float e0 = expf(l0 - mx), e1 = expf(l1 - mx), e2 = expf(l2 - mx), e3 = expf(l3 - mx); lbv[c] = e1 / (e0 + e1 + e2 + e3); } }
        __syncthreads();
        for (int jg = VCU; jg < 128; jg += GRID) { const int j = jg >> 6;
            s5_build(jg, (const float*)gptr(lds, I_S5LRE), (const float*)gptr(lds, I_S5LIM), (const float*)gptr(lds, I_S5LDT), (const float*)gptr(lds, I_S5BRE), (const float*)gptr(lds, I_S5BIM),
                     (const float*)gptr(lds, I_S5CRE), (const float*)gptr(lds, I_S5CIM), (const float*)gptr(lds, I_S5D), (bf16*)(ws + (j ? WS_TV1 : WS_TV0)), (bf16*)(ws + (j ? WS_WM1 : WS_WM0)),
                     (float*)(ws + WS_MISC + MISC_A16), lds, TID); }
        __syncthreads();
    }

            else if (op == OP_S5IN) {
                unsigned char* ws = gptr(lds, I_WS);
                unsigned vA, vB; VOFF_ROWMAJOR(vA, 1024, false); VOFF_ROWMAJOR(vB, 1024, true);
                pg8::Gemm g{(const char*)(ws + A_XN), (const char*)(ws + (jj ? WS_W_S5IN1 : WS_W_S5IN0))};
                StdOrder S; S.init(M, 2048, GRID, BX, 256 * 1024 * 2, 256 * 1024 * 2);
                EpiS5In E{(bf16*)(ws + A_XCAT), (bf16*)(ws + A_SZ_S5)};
                pg8::gemm_phase<pg8::Cfg<128, 128 * 1024 * 2, 128, 128 * 1024 * 2, 16>, EpiS5In, StdOrder, true, true>(lds + RING_OFF, g, vA, vB, S, E);
            }
            else if (op == OP_S1) {
                unsigned char* ws = gptr(lds, I_WS);
                unsigned vA, vB; VOFF_ROWMAJOR(vA, 384, false); VOFF_ROWMAJOR(vB, 256, false);
                pg8::Gemm g{(const char*)(ws + A_XCAT), (const char*)(ws + (jj ? WS_WM1 : WS_WM0))};
                GroupOrder S{GRID, VCU, (long)1024 * 384 * 2, (long)256 * 384 * 2, (long)128 * 256 * 2};
                EpiDS E{(float*)(ws + A_DS)};
                pg8::gemm_phase<pg8::Cfg<128, 128 * 384 * 2, 128, 0, 4>, EpiDS, GroupOrder, true, true>(lds + RING_OFF, g, vA, vB, S, E);
            }
            else if (op == OP_S2) {
                if (WAVE == 0) {
                    unsigned char* ws = gptr(lds, I_WS); const float* A16 = (const float*)(ws + WS_MISC + MISC_A16); const float* DS = (const float*)(ws + A_DS); bf16* Xcat = (bf16*)(ws + A_XCAT);
                    for (int bg = VCU; bg < 128; bg += GRID) { const int b = bg >> 6, g = bg & 63, p = LANE;
                        const float ar = A16[((jj * 64 + g) * 64 + p) * 2], ai = A16[((jj * 64 + g) * 64 + p) * 2 + 1];
                        float sr = 0.f, si = 0.f; const size_t rb = (size_t)g * 1024 + (size_t)b * 512;
                        for (int c0 = 0; c0 < 512; c0 += 8) { float dr[8], di[8];
#pragma unroll
                            for (int k = 0; k < 8; ++k) { dr[k] = DS[(rb + c0 + k) * 128 + p]; di[k] = DS[(rb + c0 + k) * 128 + 64 + p]; }
#pragma unroll
                            for (int k = 0; k < 8; ++k) { bf16* xr = Xcat + (rb + c0 + k) * 384 + 256; xr[p] = (bf16)f2bf(sr); xr[64 + p] = (bf16)f2bf(si);
                                const float nr = ar * sr - ai * si + dr[k], ni = ar * si + ai * sr + di[k]; sr = nr; si = ni; } } }
                }
            }
            else if (op == OP_S3) {
                unsigned char* ws = gptr(lds, I_WS);
                unsigned vA, vB; VOFF_ROWMAJOR(vA, 384, false); VOFF_ROWMAJOR(vB, 384, true);
                pg8::Gemm g{(const char*)(ws + A_XCAT), (const char*)(ws + (jj ? WS_TV1 : WS_TV0))};
                GroupOrder S{GRID, VCU, (long)1024 * 384 * 2, (long)256 * 384 * 2, (long)256 * 384 * 2};
                EpiS3 E{(bf16*)(ws + A_YG)};
                pg8::gemm_phase<pg8::Cfg<128, 128 * 384 * 2, 128, 128 * 384 * 2, 6>, EpiS3, GroupOrder, true, true>(lds + RING_OFF, g, vA, vB, S, E);
            }
            else if (op == OP_GLU) {
                unsigned char* ws = gptr(lds, I_WS);
                unsigned vA, vB; VOFF_ROWMAJOR(vB, 1024, true);
                { int tq_ = threadIdx.x; asm volatile("" : "+v"(tq_)); int R_, C_; pg8::stage_rc(tq_ * 16, R_, C_); vA = (unsigned)(((C_ >> 4) * M + R_) * 16 + (C_ & 15)) * 2u; }
                pg8::Gemm g{(const char*)(ws + A_YG), (const char*)(ws + (jj ? WS_W_S5GLU1 : WS_W_S5GLU0))};
                StdOrder S; S.init(M, 1024, GRID, BX, 256 * 16 * 2, 256 * 1024 * 2);
                EpiGlu E{(const bf16*)(ws + A_YG), (const bf16*)(ws + A_SZ_S5), (const float*)gptr(lds, I_S5BGLU) + jj * 1024, (bf16*)(ws + A_Y2_S5)};
                pg8::gemm_phase<pg8::Cfg<(long)4 * M * 16 * 2, 128 * 16 * 2, 128, 128 * 1024 * 2, 16>, EpiGlu, StdOrder, true, true>(lds + RING_OFF, g, vA, vB, S, E);
            }
            else if (op == OP_HGIN) {
                unsigned char* ws = gptr(lds, I_WS);
                unsigned vA, vB; VOFF_ROWMAJOR(vA, 1024, false); VOFF_ROWMAJOR(vB, 1024, false);
                pg8::Gemm g{(const char*)(ws + A_XN), (const char*)(ws + WS_W_HGIN)};
                StdOrder S; S.init(M, 4096, GRID, BX, 256 * 1024 * 2, 256 * 1024 * 2);
                EpiHgIn E{(const float*)(ws + WS_MISC + MISC_LB), (bf16*)(ws + A_Q_HG), (_Float16*)(ws + A_F_HG), (bf16*)(ws + A_V_HG), (bf16*)(ws + A_SZ_HG)};
                pg8::gemm_phase<pg8::Cfg<128, 128 * 1024 * 2, 128, 128 * 1024 * 2, 16>, EpiHgIn, StdOrder, true, true>(lds + RING_OFF, g, vA, vB, S, E);
            }
            else if (op == OP_HGREC) {
                unsigned char* ws = gptr(lds, I_WS); const int lane = LANE;
                const bf16* Qh = (const bf16*)(ws + A_Q_HG); const _Float16* Fh = (const _Float16*)(ws + A_F_HG); const bf16* Vh = (const bf16*)(ws + A_V_HG); bf16* Oh = (bf16*)(ws + A_O_HG);
                for (int item = GW; item < 2048; item += NGW) { const int b = item >> 10, h = (item >> 7) & 7, vc = item & 127;
                    float s0 = 0.f, s1 = 0.f; const size_t rb = (size_t)b * SEQ;
                    for (int t0 = 0; t0 < SEQ; t0 += 8) { float q0[8], q1[8], f0[8], f1[8], vv[8], part[8];
#pragma unroll
                        for (int k = 0; k < 8; ++k) { const size_t off = (rb + t0 + k) * 1024 + h * 128;
                            q0[k] = bf2f(Qh[off + lane]); q1[k] = bf2f(Qh[off + 64 + lane]); f0[k] = (float)Fh[off + lane]; f1[k] = (float)Fh[off + 64 + lane]; vv[k] = bf2f(Vh[off + vc]); }
#pragma unroll
                        for (int k = 0; k < 8; ++k) { s0 = f0[k] * s0 + (1.f - f0[k]) * vv[k]; s1 = f1[k] * s1 + (1.f - f1[k]) * vv[k]; part[k] = q0[k] * s0 + q1[k] * s1; }
#pragma unroll
                        for (int k = 0; k < 8; ++k) part[k] = wave_sum(part[k]);
                        float mine = part[0];
#pragma unroll
                        for (int k = 1; k < 8; ++k) mine = (lane == k) ? part[k] : mine;
                        if (lane < 8) Oh[(rb + t0 + lane) * 1024 + h * 128 + vc] = (bf16)f2bf(mine); } }
            }
            else if (op == OP_HGNORM) {
                unsigned char* ws = gptr(lds, I_WS); const int lane = LANE; const float* hg_norm = (const float*)gptr(lds, I_HGNORM);
                const bf16* Oh = (const bf16*)(ws + A_O_HG); const bf16* SZ = (const bf16*)(ws + A_SZ_HG); bf16* Y2 = (bf16*)(ws + A_Y2_HG);
                for (int m = GW; m < M; m += NGW) { const size_t off = (size_t)m * 1024 + lane * 16;
                    const v4u o0 = *(const v4u*)(Oh + off), o1 = *(const v4u*)(Oh + off + 8), z0 = *(const v4u*)(SZ + off), z1 = *(const v4u*)(SZ + off + 8);
                    float v[16] = {bf_lo(o0.x), bf_hi(o0.x), bf_lo(o0.y), bf_hi(o0.y), bf_lo(o0.z), bf_hi(o0.z), bf_lo(o0.w), bf_hi(o0.w), bf_lo(o1.x), bf_hi(o1.x), bf_lo(o1.y), bf_hi(o1.y), bf_lo(o1.z), bf_hi(o1.z), bf_lo(o1.w), bf_hi(o1.w)};
                    const float zz[16] = {bf_lo(z0.x), bf_hi(z0.x), bf_lo(z0.y), bf_hi(z0.y), bf_lo(z0.z), bf_hi(z0.z), bf_lo(z0.w), bf_hi(z0.w), bf_lo(z1.x), bf_hi(z1.x), bf_lo(z1.y), bf_hi(z1.y), bf_lo(z1.z), bf_hi(z1.z), bf_lo(z1.w), bf_hi(z1.w)};
                    float ss = 0.f;
#pragma unroll
                    for (int e = 0; e < 16; ++e) ss += v[e] * v[e];
                    ss = xor_sum_4(xor_sum_2(xor_sum_1(ss)));
                    const float rs = 1.f / sqrtf(ss * (1.f / 128.f) + NORM_EPS);
                    const f32x4* gn = (const f32x4*)(hg_norm + lane * 16); const f32x4 g0 = gn[0], g1 = gn[1], g2 = gn[2], g3 = gn[3];
                    const float gg[16] = {g0.x, g0.y, g0.z, g0.w, g1.x, g1.y, g1.z, g1.w, g2.x, g2.y, g2.z, g2.w, g3.x, g3.y, g3.z, g3.w};
#pragma unroll
                    for (int e = 0; e < 16; ++e) v[e] = v[e] * rs * gg[e] * zz[e];
                    v4u w0, w1; w0.x = pk2(v[0], v[1]); w0.y = pk2(v[2], v[3]); w0.z = pk2(v[4], v[5]); w0.w = pk2(v[6], v[7]); w1.x = pk2(v[8], v[9]); w1.y = pk2(v[10], v[11]); w1.z = pk2(v[12], v[13]); w1.w = pk2(v[14], v[15]);
                    *(v4u*)(Y2 + off) = w0; *(v4u*)(Y2 + off + 8) = w1; }
            }
            else if (op == OP_ATIN) {
                unsigned char* ws = gptr(lds, I_WS);
                unsigned vA, vB; VOFF_ROWMAJOR(vA, 1024, false); VOFF_ROWMAJOR(vB, 1024, false);
                pg8::Gemm g{(const char*)(ws + A_XN), (const char*)(ws + WS_W_ATIN)};
                StdOrder S; S.init(M, 2560, GRID, BX, 256 * 1024 * 2, 256 * 1024 * 2);
                EpiAtIn E{(const float*)gptr(lds, I_ATBIN), (const float*)(ws + WS_ROPE), (const float*)(ws + WS_ROPE) + (size_t)M * 32, (bf16*)(ws + A_Q_AT), (bf16*)(ws + A_K_AT), (bf16*)(ws + A_V_AT), (bf16*)(ws + A_SZ_AT)};
                pg8::gemm_phase<pg8::Cfg<128, 128 * 1024 * 2, 128, 128 * 1024 * 2, 16>, EpiAtIn, StdOrder, true, true>(lds + RING_OFF, g, vA, vB, S, E);
            }
            else if (op == OP_ATT) {
                unsigned char* ws = gptr(lds, I_WS); const int lane = LANE; const float* at_sinks = (const float*)gptr(lds, I_ATSINK);
                const bf16* Qa = (const bf16*)(ws + A_Q_AT); const bf16* Ka = (const bf16*)(ws + A_K_AT); const bf16* Va = (const bf16*)(ws + A_V_AT); const bf16* SZ = (const bf16*)(ws + A_SZ_AT); bf16* Y2 = (bf16*)(ws + A_Y2_AT);
                for (int item = GW; item < 4096; item += NGW) { const int b = item >> 11, hq = (item >> 7) & 15, blk = item & 127, hk = hq >> 2;
                    const int q0 = blk * 64, qi = q0 + lane; const size_t row = (size_t)b * SEQ + qi;
                    float q[64], acc[64];
#pragma unroll
                    for (int c = 0; c < 8; ++c) { const v4u w = *(const v4u*)(Qa + row * 1024 + (hq >> 2) * 256 + (hq & 3) * 32 + (c >> 2) * 128 + (c & 3) * 8);
                        q[c * 8 + 0] = bf_lo(w.x) * 0.125f; q[c * 8 + 1] = bf_hi(w.x) * 0.125f; q[c * 8 + 2] = bf_lo(w.y) * 0.125f; q[c * 8 + 3] = bf_hi(w.y) * 0.125f;
                        q[c * 8 + 4] = bf_lo(w.z) * 0.125f; q[c * 8 + 5] = bf_hi(w.z) * 0.125f; q[c * 8 + 6] = bf_lo(w.w) * 0.125f; q[c * 8 + 7] = bf_hi(w.w) * 0.125f; }
#pragma unroll
                    for (int d = 0; d < 64; ++d) acc[d] = 0.f;
                    float mx = -INFINITY, l = 0.f;
                    const int kstart = (q0 - 127 > 0) ? q0 - 127 : 0, kend = q0 + 63;
                    for (int kp = kstart; kp <= kend; ++kp) { const size_t kr = ((size_t)b * SEQ + kp) * 256; const size_t kq = kr + hk * 32; const size_t kv = kr + hk * 64;
                        float s = 0.f;
#pragma unroll
                        for (int c = 0; c < 8; ++c) { const v4u w = *(const v4u*)(Ka + kq + (c >> 2) * 128 + (c & 3) * 8);
                            s += q[c * 8 + 0] * bf_lo(w.x) + q[c * 8 + 1] * bf_hi(w.x) + q[c * 8 + 2] * bf_lo(w.y) + q[c * 8 + 3] * bf_hi(w.y) + q[c * 8 + 4] * bf_lo(w.z) + q[c * 8 + 5] * bf_hi(w.z) + q[c * 8 + 6] * bf_lo(w.w) + q[c * 8 + 7] * bf_hi(w.w); }
                        const bool valid = (kp <= qi) && (kp > qi - 128);
                        const float mn = valid ? fmaxf(mx, s) : mx;
                        const float alpha = (mx == -INFINITY) ? 0.f : __expf(mx - mn);
                        const float pz = valid ? __expf(s - mn) : 0.f;
                        mx = mn; l = l * alpha + pz;
#pragma unroll
                        for (int c = 0; c < 8; ++c) { const v4u w = *(const v4u*)(Va + kv + c * 8);
                            acc[c * 8 + 0] = acc[c * 8 + 0] * alpha + pz * bf_lo(w.x); acc[c * 8 + 1] = acc[c * 8 + 1] * alpha + pz * bf_hi(w.x);
                            acc[c * 8 + 2] = acc[c * 8 + 2] * alpha + pz * bf_lo(w.y); acc[c * 8 + 3] = acc[c * 8 + 3] * alpha + pz * bf_hi(w.y);
                            acc[c * 8 + 4] = acc[c * 8 + 4] * alpha + pz * bf_lo(w.z); acc[c * 8 + 5] = acc[c * 8 + 5] * alpha + pz * bf_hi(w.z);
                            acc[c * 8 + 6] = acc[c * 8 + 6] * alpha + pz * bf_lo(w.w); acc[c * 8 + 7] = acc[c * 8 + 7] * alpha + pz * bf_hi(w.w); } }
                    const float sink = at_sinks[hq], mf = fmaxf(mx, sink), sc = __expf(mx - mf), den = l * sc + __expf(sink - mf), f = sc / den;
#pragma unroll
                    for (int c = 0; c < 8; ++c) { const v4u z = *(const v4u*)(SZ + row * 1024 + hq * 64 + c * 8); v4u w;
                        w.x = pk2(acc[c * 8 + 0] * f * bf_lo(z.x), acc[c * 8 + 1] * f * bf_hi(z.x)); w.y = pk2(acc[c * 8 + 2] * f * bf_lo(z.y), acc[c * 8 + 3] * f * bf_hi(z.y));
                        w.z = pk2(acc[c * 8 + 4] * f * bf_lo(z.z), acc[c * 8 + 5] * f * bf_hi(z.z)); w.w = pk2(acc[c * 8 + 6] * f * bf_lo(z.w), acc[c * 8 + 7] * f * bf_hi(z.w));
                        *(v4u*)(Y2 + row * 1024 + hq * 64 + c * 8) = w; } }
            }
        else if (op == OP_OUT) {
            unsigned char* ws = gptr(lds, I_WS);
            const size_t a_y2 = (kind == 0) ? A_Y2_S5 : (kind == 1) ? A_Y2_HG : A_Y2_AT, a_w = (kind == 0) ? (jj ? WS_W_S5OUT1 : WS_W_S5OUT0) : (kind == 1) ? WS_W_HGOUT : WS_W_ATOUT, a_out = (kind == 0) ? A_OUT_S5 : (kind == 1) ? A_OUT_HG : A_OUT_AT;
            unsigned vA, vB; VOFF_ROWMAJOR(vA, 1024, false); VOFF_ROWMAJOR(vB, 1024, false);
            pg8::Gemm g{(const char*)(ws + a_y2), (const char*)(ws + a_w)};
            StdOrder S; S.init(M, 1024, GRID, BX, 256 * 1024 * 2, 256 * 1024 * 2);
            EpiF32 E{(float*)(ws + a_out)};
            pg8::gemm_phase<pg8::Cfg<128, 128 * 1024 * 2, 128, 128 * 1024 * 2, 16>, EpiF32, StdOrder, true, true>(lds + RING_OFF, g, vA, vB, S, E);
        }
        else if (op == OP_NORM) {
            unsigned char* ws = gptr(lds, I_WS); const int lane = LANE;
            const size_t a_out = (kind == 0) ? A_OUT_S5 : (kind == 1) ? A_OUT_HG : A_OUT_AT;
            const float* OB = (const float*)(ws + a_out); float* hout = (float*)gptr(lds, I_OUT); const float* hsrc = (layer == 0) ? (const float*)gptr(lds, I_X) : hout; bf16* XN = (bf16*)(ws + A_XN);
            const float* gpost = (const float*)gptr(lds, I_NPOST) + layer * 1024; const float* gpre = (const float*)gptr(lds, I_NPRE) + (layer < 3 ? layer + 1 : 0) * 1024;
            for (int m = GW; m < M; m += NGW) { const f32x4* orow = (const f32x4*)(OB + (size_t)m * 1024) + lane; const f32x4* hrow = (const f32x4*)(hsrc + (size_t)m * 1024) + lane;
                f32x4 o[4], h[4]; float ss = 0.f;
#pragma unroll
                for (int j = 0; j < 4; ++j) { o[j] = orow[64 * j]; h[j] = hrow[64 * j]; ss += (o[j].x * o[j].x + o[j].y * o[j].y) + (o[j].z * o[j].z + o[j].w * o[j].w); }
                const float rs = 1.f / sqrtf(wave_sum(ss) * (1.f / 1024.f) + NORM_EPS); float s2 = 0.f;
                f32x4* hd = (f32x4*)(hout + (size_t)m * 1024) + lane;
#pragma unroll
                for (int j = 0; j < 4; ++j) { const f32x4 gp = ((const f32x4*)gpost)[lane + 64 * j]; h[j] = h[j] + o[j] * rs * gp; hd[64 * j] = h[j];
                    s2 += (h[j].x * h[j].x + h[j].y * h[j].y) + (h[j].z * h[j].z + h[j].w * h[j].w); }
                if (layer < 3) { const float r2 = 1.f / sqrtf(wave_sum(s2) * (1.f / 1024.f) + NORM_EPS); v2u* o8 = (v2u*)(XN + (size_t)m * 1024) + lane;
#pragma unroll
                    for (int j = 0; j < 4; ++j) { const f32x4 gg = ((const f32x4*)gpre)[lane + 64 * j]; v2u w; w.x = pk2(h[j].x * r2 * gg.x, h[j].y * r2 * gg.y); w.y = pk2(h[j].z * r2 * gg.z, h[j].w * r2 * gg.w); o8[64 * j] = w; } } }
        }
        if (ph + 1 < hi) xcd_barrier(bar);
    }
}

extern "C" void kernel_launch(void* const* d_in, const int* in_sizes, int n_in, void* d_out, int out_size, void* d_ws, size_t ws_size, hipStream_t stream) {
    static int grid = 0;
    if (grid == 0) {
        if (n_in != 24 || out_size != M * DM || ws_size < WS_END) { fprintf(stderr, "kernel_launch: unexpected sizes n_in %d out %d ws %zu\n", n_in, out_size, ws_size); grid = -1; return; }
        int dev = 0, cus = 0, per_cu = 0;
        if (hipGetDevice(&dev) != hipSuccess || hipDeviceGetAttribute(&cus, hipDeviceAttributeMultiprocessorCount, dev) != hipSuccess) { grid = -1; return; }
        if (hipFuncSetAttribute((const void*)mk_fwd, hipFuncAttributeMaxDynamicSharedMemorySize, LDS_BYTES) != hipSuccess) { fprintf(stderr, "kernel_launch: hipFuncSetAttribute failed\n"); grid = -1; return; }
        if (hipOccupancyMaxActiveBlocksPerMultiprocessor(&per_cu, (const void*)mk_fwd, NWAVES * 64, LDS_BYTES) != hipSuccess || per_cu < 1) { fprintf(stderr, "kernel_launch: occupancy query says %d blocks per CU\n", per_cu); (void)hipGetLastError(); grid = -1; return; }
        grid = cus;
    }
    if (grid < 0) return;
    (void)hipMemsetAsync((char*)d_ws + WS_CTL, 0, CTL_ZERO_BYTES, stream);
    Args a{};
    for (int i = 0; i < 24; ++i) a.in[i] = d_in[i];
    a.out = (float*)d_out; a.ws = (unsigned char*)d_ws;
#if MK_N_LAUNCHES == 1
    a.ph_lo = 0; a.ph_hi = NPHASES;
    hipLaunchKernelGGL(mk_fwd, dim3(grid), dim3(NWAVES * 64), LDS_BYTES, stream, a);
#else
    for (int p = 0; p < NPHASES; ++p) { a.ph_lo = p; a.ph_hi = p + 1; hipLaunchKernelGGL(mk_fwd, dim3(grid), dim3(NWAVES * 64), LDS_BYTES, stream, a); }
#endif
}
```

```cpp
#include <hip/hip_runtime.h>
#include <cstdio>
#include <cstdint>

namespace pg8 {
#define PG8_LAS __attribute__((address_space(3)))
typedef unsigned short bf16_t;
typedef short bf16x8 __attribute__((ext_vector_type(8)));
typedef float f32x4 __attribute__((ext_vector_type(4)));
typedef unsigned u32x4 __attribute__((ext_vector_type(4)));
typedef unsigned u32x2 __attribute__((ext_vector_type(2)));
constexpr int BM = 256, BK = 64, HALF = 128, HTB = HALF * BK * 2  , STAGE_BYTES = 8 * HTB, NXCD = 8, WGM = 8;

__host__ __device__ __forceinline__ int lds_byte(int r, int c) { const int st = (r >> 4) * 2 + (c >> 5), rr = r & 15, cc = c & 31, ob = rr * 64 + cc * 2; return st * 1024 + (ob ^ (((ob >> 9) & 1) << 5)); }
__host__ __device__ __forceinline__ void stage_rc(int b, int& R, int& C) { const int st = b / 1024, sb = b % 1024, swz = sb ^ (((sb >> 9) & 1) << 5); R = (st >> 1) * 16 + swz / 64; C = (st & 1) * 32 + (swz % 64) / 2; }
__host__ __device__ __forceinline__ int perm32(int rho) { const int n = rho >> 4, i = rho & 15; return 8 * (i >> 2) + 4 * n + (i & 3); }

struct Unit { int pm, pn; long aoff, boff; };
struct Gemm { const char* A; const char* Bt; };
template <long KSA, long HSA, long KSB, long HSB, int NT> struct Cfg { static constexpr long kstepA = KSA, hstepA = HSA, kstepB = KSB, hstepB = HSB, dA = HSA / 2, dB = (HSB ? HSB / 2 : 64 * 256 * 2); static constexpr int nt = NT; };

__device__ __forceinline__ unsigned cvt_pk_bf16(float lo, float hi) { unsigned r; asm volatile("v_cvt_pk_bf16_f32 %0, %1, %2" : "=v"(r) : "v"(lo), "v"(hi)); return r; }

template <class C, class Epi, class Sched, bool ALIGN_EPI = false, bool SP2 = false>
__device__ __forceinline__ void gemm_phase(PG8_LAS unsigned char* lds, const Gemm g, const unsigned voffA, const unsigned voffB, const Sched& S, const Epi& E) {
    int tid_ = threadIdx.x; asm volatile("" : "+v"(tid_));
    const int tid = tid_, wid = __builtin_amdgcn_readfirstlane(tid >> 6), lane = tid & 63, wr = wid >> 2, wc = wid & 3, fr = lane & 15, fq = lane >> 4;
    constexpr int nt = C::nt;
    constexpr long kstepA = C::kstepA, hstepA = C::hstepA, kstepB = C::kstepB, hstepB = C::hstepB;
    const unsigned ldsw = (unsigned)wid * 1024u;
    const int aoff = lds_byte(wr * 64 + fr, fq * 8), boff = lds_byte(wc * 32 + fr, fq * 8);
#define PG8_SA(b, h) (((b) * 2 + (h)) * HTB)
#define PG8_SB(b, h) ((4 + (b) * 2 + (h)) * HTB)
#define PG8_STAGE(bufoff, gbase, voff) do { _Pragma("unroll") for (int _i = 0; _i < 2; ++_i) \
        __builtin_amdgcn_global_load_lds((const unsigned*)((const char*)(gbase) + (size_t)_i * PG8_D_##voff + (voff)), (PG8_LAS unsigned*)(lds + (bufoff) + ldsw + _i * 8192), 16, 0, 0); } while (0)
#define PG8_D_voffA C::dA
#define PG8_D_voffB C::dB
#define PG8_LDA(dst, b, h) do { _Pragma("unroll") for (int m = 0; m < 4; ++m) _Pragma("unroll") for (int k = 0; k < 2; ++k) dst[m][k] = *(const PG8_LAS bf16x8*)(lds + PG8_SA(b, h) + aoff + m * 2048 + k * 1024); } while (0)
#define PG8_LDB(dst, b, h) do { _Pragma("unroll") for (int n = 0; n < 2; ++n) _Pragma("unroll") for (int k = 0; k < 2; ++k) dst[n][k] = *(const PG8_LAS bf16x8*)(lds + PG8_SB(b, h) + boff + n * 2048 + k * 1024); } while (0)
#define PG8_MMA(ai, bj, At, Bt) do { __builtin_amdgcn_s_setprio(1); _Pragma("unroll") for (int m = 0; m < 4; ++m) _Pragma("unroll") for (int n = 0; n < 2; ++n) _Pragma("unroll") for (int k = 0; k < 2; ++k) \
        acc[ai][bj][m][n] = __builtin_amdgcn_mfma_f32_16x16x32_bf16(Bt[n][k], At[m][k], acc[ai][bj][m][n], 0, 0, 0); __builtin_amdgcn_s_setprio(0); } while (0)
#define PG8_WAIT_V(n) asm volatile("s_waitcnt vmcnt(" #n ")" ::: "memory")
#define PG8_WAIT_L(n) asm volatile("s_waitcnt lgkmcnt(" #n ")" ::: "memory")
#define PG8_BAR __builtin_amdgcn_s_barrier()
#define PG8_SCHED __builtin_amdgcn_sched_barrier(0)
    Unit cur, nxt; int ui = 0;
    if (!S.next(0, cur)) return;
    f32x4 acc[2][2][4][2];
#pragma unroll
    for (int a = 0; a < 2; ++a)
#pragma unroll
        for (int b = 0; b < 2; ++b)
#pragma unroll
            for (int m = 0; m < 4; ++m)
#pragma unroll
                for (int n = 0; n < 2; ++n) acc[a][b][m][n] = (f32x4){0.f, 0.f, 0.f, 0.f};
    bf16x8 At[4][2], B0[2][2], B1[2][2];
    const char* cA = g.A + cur.aoff; const char* cB = g.Bt + cur.boff;
    if constexpr (SP2) {
        PG8_STAGE(PG8_SB(0, 0), cB, voffB); PG8_STAGE(PG8_SB(0, 1), cB + hstepB, voffB); PG8_STAGE(PG8_SA(0, 0), cA, voffA); PG8_STAGE(PG8_SA(0, 1), cA + hstepA, voffA);
        if (wr == 1) PG8_BAR;
        PG8_WAIT_V(2); PG8_BAR;
        PG8_STAGE(PG8_SB(1, 0), cB + kstepB, voffB); PG8_STAGE(PG8_SA(1, 0), cA + kstepA, voffA); PG8_STAGE(PG8_SB(1, 1), cB + hstepB + kstepB, voffB);
        PG8_WAIT_V(6); PG8_BAR;
    } else {
        PG8_STAGE(PG8_SB(0, 0), cB, voffB); PG8_STAGE(PG8_SA(0, 0), cA, voffA); PG8_STAGE(PG8_SB(0, 1), cB + hstepB, voffB); PG8_STAGE(PG8_SA(0, 1), cA + hstepA, voffA);
        if (wr == 1) PG8_BAR;
        PG8_WAIT_V(4); PG8_BAR;
        PG8_STAGE(PG8_SB(1, 0), cB + kstepB, voffB); PG8_STAGE(PG8_SA(1, 0), cA + kstepA, voffA); PG8_STAGE(PG8_SB(1, 1), cB + hstepB + kstepB, voffB);
        PG8_WAIT_V(6); PG8_BAR;
    }
    for (;;) {
        const bool has_next = S.next(ui + 1, nxt);
        const char* nA = has_next ? g.A + nxt.aoff : cA; const char* nB = has_next ? g.Bt + nxt.boff : cB;
        for (int t = 0; t < nt; t += 2) {
            const bool last = (t == nt - 2);
            const char* a1 = cA + (size_t)(t + 1) * kstepA;
            const char* a2 = last ? nA : cA + (size_t)(t + 2) * kstepA; const char* b2 = last ? nB : cB + (size_t)(t + 2) * kstepB;
            const char* a3 = a2 + kstepA; const char* b3 = b2 + kstepB;
            if constexpr (SP2) {
            PG8_LDB(B0, 0, 0); PG8_LDB(B1, 0, 1); PG8_SCHED; PG8_LDA(At, 0, 0); PG8_STAGE(PG8_SA(1, 1), a1 + hstepA, voffA);
            PG8_WAIT_V(8); PG8_WAIT_L(0); PG8_BAR; PG8_MMA(0, 0, At, B0); PG8_MMA(0, 1, At, B1); PG8_BAR; PG8_SCHED;
            PG8_LDA(At, 0, 1); PG8_STAGE(PG8_SB(0, 0), b2, voffB); PG8_STAGE(PG8_SB(0, 1), b2 + hstepB, voffB); PG8_STAGE(PG8_SA(0, 0), a2, voffA);
            PG8_WAIT_V(8); PG8_WAIT_L(0); PG8_BAR; PG8_MMA(1, 0, At, B0); PG8_MMA(1, 1, At, B1); PG8_BAR; PG8_SCHED;
            PG8_LDB(B0, 1, 0); PG8_LDB(B1, 1, 1); PG8_SCHED; PG8_LDA(At, 1, 0); PG8_STAGE(PG8_SA(0, 1), a2 + hstepA, voffA);
            PG8_WAIT_V(8); PG8_WAIT_L(0); PG8_BAR; PG8_MMA(0, 0, At, B0); PG8_MMA(0, 1, At, B1); PG8_BAR; PG8_SCHED;
            PG8_LDA(At, 1, 1); PG8_STAGE(PG8_SB(1, 0), b3, voffB); PG8_STAGE(PG8_SB(1, 1), b3 + hstepB, voffB); PG8_STAGE(PG8_SA(1, 0), a3, voffA);
            PG8_WAIT_V(8); PG8_WAIT_L(0); PG8_BAR; PG8_MMA(1, 0, At, B0); PG8_MMA(1, 1, At, B1); PG8_BAR; PG8_SCHED;
            } else {
            PG8_LDB(B0, 0, 0); PG8_SCHED; PG8_LDA(At, 0, 0); PG8_STAGE(PG8_SA(1, 1), a1 + hstepA, voffA);
            PG8_WAIT_L(8); PG8_BAR; PG8_WAIT_L(0); PG8_MMA(0, 0, At, B0); PG8_BAR; PG8_SCHED;
            PG8_LDB(B1, 0, 1); PG8_STAGE(PG8_SB(0, 0), b2, voffB);
            PG8_BAR; PG8_WAIT_L(0); PG8_MMA(0, 1, At, B1); PG8_BAR;
            PG8_LDA(At, 0, 1); PG8_STAGE(PG8_SA(0, 0), a2, voffA);
            PG8_BAR; PG8_WAIT_L(0); PG8_MMA(1, 0, At, B0); PG8_BAR; PG8_SCHED;
            PG8_STAGE(PG8_SB(0, 1), b2 + hstepB, voffB);
            PG8_WAIT_V(6); PG8_BAR; PG8_MMA(1, 1, At, B1); PG8_BAR;
            PG8_LDB(B0, 1, 0); PG8_SCHED; PG8_LDA(At, 1, 0); PG8_STAGE(PG8_SA(0, 1), a2 + hstepA, voffA);
            PG8_WAIT_L(8); PG8_BAR; PG8_WAIT_L(0); PG8_MMA(0, 0, At, B0); PG8_BAR; PG8_SCHED;
            PG8_LDB(B1, 1, 1); PG8_STAGE(PG8_SB(1, 0), b3, voffB);
            PG8_BAR; PG8_WAIT_L(0); PG8_MMA(0, 1, At, B1); PG8_BAR;
            PG8_LDA(At, 1, 1); PG8_STAGE(PG8_SA(1, 0), a3, voffA);
            PG8_BAR; PG8_WAIT_L(0); PG8_MMA(1, 0, At, B0); PG8_BAR; PG8_SCHED;
            PG8_STAGE(PG8_SB(1, 1), b3 + hstepB, voffB);
            PG8_WAIT_V(6); PG8_BAR; PG8_MMA(1, 1, At, B1); PG8_BAR;
            }
        }
        if constexpr (ALIGN_EPI) { if (wr == 0) PG8_BAR; }
        if constexpr (!Epi::AFTER_DRAIN) { E(acc, cur, wr, wc, fr, fq); }
        if (!has_next) break;
#pragma unroll
        for (int a = 0; a < 2; ++a)
#pragma unroll
            for (int b = 0; b < 2; ++b)
#pragma unroll
                for (int m = 0; m < 4; ++m)
#pragma unroll
                    for (int n = 0; n < 2; ++n) acc[a][b][m][n] = (f32x4){0.f, 0.f, 0.f, 0.f};
        cur = nxt; cA = nA; cB = nB; ++ui;
        if constexpr (ALIGN_EPI) { if (wr == 1) PG8_BAR; }
    }
    PG8_WAIT_V(0);
    if constexpr (!ALIGN_EPI) { if (wr == 0) PG8_BAR; }
    PG8_BAR;
    if constexpr (Epi::AFTER_DRAIN) { E.fused(acc, cur, wr, wc, fr, fq, lds, wid, lane); }
#undef PG8_SA
#undef PG8_SB
#undef PG8_STAGE
#undef PG8_D_voffA
#undef PG8_D_voffB
#undef PG8_LDA
#undef PG8_LDB
#undef PG8_MMA
#undef PG8_WAIT_V
#undef PG8_WAIT_L
#undef PG8_BAR
#undef PG8_SCHED
}
}

constexpr int NWAVES = 8;
constexpr int BATCH = 2, SEQ = 8192, DM = 1024, M = BATCH * SEQ;
constexpr float NORM_EPS = 1e-6f;
constexpr int NPHASES = 25;
#ifndef MK_N_LAUNCHES
#define MK_N_LAUNCHES 1
#endif

constexpr size_t MiB = 1u << 20;
constexpr size_t WS_CTL = 0, CTL_ZERO_BYTES = 1 * MiB;
constexpr size_t WS_MISC = 1 * MiB;
constexpr size_t MISC_LB = 0, MISC_A16 = 65536;
constexpr size_t WS_W_S5IN0 = 2 * MiB, WS_W_S5GLU0 = 6 * MiB, WS_W_S5OUT0 = 8 * MiB, WS_W_S5IN1 = 10 * MiB, WS_W_S5GLU1 = 14 * MiB, WS_W_S5OUT1 = 16 * MiB;
constexpr size_t WS_W_HGIN = 18 * MiB, WS_W_HGOUT = 26 * MiB, WS_W_ATIN = 28 * MiB, WS_W_ATOUT = 33 * MiB;
constexpr size_t WS_TV1 = 36 * MiB, WS_WM1 = 48 * MiB, WS_TV0 = 56 * MiB, WS_WM0 = 68 * MiB;
constexpr size_t WS_ROPE = 52 * MiB;
constexpr size_t WS_ACT = 72 * MiB;
constexpr size_t A_XN = WS_ACT + 0 * MiB;
constexpr size_t A_Y2_S5 = WS_ACT + 0 * MiB;
constexpr size_t A_XCAT = WS_ACT + 32 * MiB;
constexpr size_t A_SZ_S5 = WS_ACT + 80 * MiB;
constexpr size_t A_DS = WS_ACT + 112 * MiB;
constexpr size_t A_YG = WS_ACT + 144 * MiB;
constexpr size_t A_OUT_S5 = WS_ACT + 32 * MiB;
constexpr size_t A_XN_HG = 56 * MiB, A_ST_HG = 56 * MiB, A_QT_HG = 88 * MiB, A_Y2_HG = 88 * MiB, A_KT_HG = 120 * MiB, A_KH_HG = 152 * MiB, A_V_HG = 184 * MiB, A_SZ_HG = 216 * MiB, A_E_HG = 248 * MiB, A_DD_HG = 250 * MiB, A_OUT_HG = 120 * MiB;
constexpr size_t A_Q_AT = WS_ACT + 32 * MiB, A_K_AT = WS_ACT + 64 * MiB, A_V_AT = WS_ACT + 72 * MiB, A_SZ_AT = WS_ACT + 80 * MiB, A_Y2_AT = WS_ACT + 112 * MiB, A_OUT_AT = WS_ACT + 32 * MiB;
constexpr size_t WS_END = 256 * MiB;
constexpr int CW_BAR = 4096;

constexpr int RING_OFF = 0, RING_BYTES = 131072;
constexpr int LDSCTL_OFF = RING_BYTES, MISC_OFF = LDSCTL_OFF + 320;
constexpr int LDS_BYTES = 147456;

#define GAS __attribute__((address_space(1)))
#define LAS __attribute__((address_space(3)))
typedef unsigned short bf16;
typedef unsigned v4u __attribute__((ext_vector_type(4)));
typedef unsigned v2u __attribute__((ext_vector_type(2)));
typedef float f32x4 __attribute__((ext_vector_type(4)));
#define LDS_WAIT() asm volatile("s_waitcnt lgkmcnt(0)" ::: "memory")
#define VM_WAIT() asm volatile("s_waitcnt vmcnt(0)" ::: "memory")
__device__ __forceinline__ unsigned f2bf(float f) { unsigned u = __builtin_bit_cast(unsigned, f); return (u + 0x7fffu + ((u >> 16) & 1u)) >> 16; }
__device__ __forceinline__ unsigned pk2(float lo, float hi) { return f2bf(lo) | (f2bf(hi) << 16); }
__device__ __forceinline__ float bf_lo(unsigned w) { return __builtin_bit_cast(float, w << 16); }
__device__ __forceinline__ float bf_hi(unsigned w) { return __builtin_bit_cast(float, w & 0xffff0000u); }
__device__ __forceinline__ float bf2f(bf16 h) { return __builtin_bit_cast(float, (unsigned)h << 16); }
__device__ __forceinline__ float sigmoid_f(float x) { return 1.f / (1.f + __expf(-x)); }
__device__ __forceinline__ float silu_f(float x) { return x / (1.f + __expf(-x)); }
__device__ __forceinline__ float gelu_tanh_f(float x) { const float u = 0.7978845608028654f * (x + 0.044715f * x * x * x); const float e = __expf(2.f * u); return 0.5f * x * (2.f - 2.f / (1.f + e)); }
template <int PAT> __device__ __forceinline__ float swz_f(float v) { return __builtin_bit_cast(float, __builtin_amdgcn_ds_swizzle(__builtin_bit_cast(int, v), PAT)); }
__device__ __forceinline__ float xor_sum_1(float v)  { return v + swz_f<0x041f>(v); }
__device__ __forceinline__ float xor_sum_2(float v)  { return v + swz_f<0x081f>(v); }
__device__ __forceinline__ float xor_sum_4(float v)  { return v + swz_f<0x101f>(v); }
__device__ __forceinline__ float xor_sum_8(float v)  { return v + swz_f<0x201f>(v); }
__device__ __forceinline__ float xor_sum_16(float v) { return v + swz_f<0x401f>(v); }
__device__ __forceinline__ float xor_sum_32(float v) { const unsigned u = __builtin_bit_cast(unsigned, v); auto r = __builtin_amdgcn_permlane32_swap(u, u, false, false); return __builtin_bit_cast(float, (unsigned)r[0]) + __builtin_bit_cast(float, (unsigned)r[1]); }
__device__ __forceinline__ float wave_sum(float v) { return xor_sum_32(xor_sum_16(xor_sum_8(xor_sum_4(xor_sum_2(xor_sum_1(v)))))); }

#define TID ({ int t_ = threadIdx.x; asm volatile("" : "+v"(t_)); t_; })
#define LANE (TID & 63)
#define WAVE (__builtin_amdgcn_readfirstlane(TID >> 6))
#define GRID ({ int g_ = gridDim.x; asm volatile("" : "+s"(g_)); g_; })
#define BX ({ int b_ = blockIdx.x; asm volatile("" : "+s"(b_)); b_; })
#define VCU ((GRID % 8 == 0) ? (BX % 8) * (GRID / 8) + BX / 8 : BX)
#define GW (VCU * NWAVES + WAVE)
#define NGW (GRID * NWAVES)

#define XB_TMO      128
#define XB_XCNT(j)  (256  + 64 * (j))
#define XB_XSUB(j)  (1280 + 64 * (j))
#define XB_XGEN(j)  (2304 + 64 * (j))
#define XB_TOP      3328
#define XB_TOPGEN   3392
#define XCD_BAR_WORDS 3456
#define XB_SPIN_CAP (1u << 18)
__device__ __forceinline__ unsigned xb_ld(unsigned* p)              { return __hip_atomic_load(p, __ATOMIC_RELAXED, __HIP_MEMORY_SCOPE_AGENT); }
__device__ __forceinline__ unsigned xb_add(unsigned* p, unsigned v) { return __hip_atomic_fetch_add(p, v, __ATOMIC_RELAXED, __HIP_MEMORY_SCOPE_AGENT); }
__device__ __forceinline__ unsigned xb_xcc_id() { return (unsigned)__builtin_amdgcn_s_getreg((3 << 11) | 20) & 0xFu; }
#define XB_SPIN(cond, bar) do { unsigned _sp = 0; while (cond) { __builtin_amdgcn_s_sleep(1); \
    if ((++_sp & 255u) == 0u) { if (xb_ld(&(bar)[XB_TMO])) break; if (_sp > XB_SPIN_CAP) { atomicAdd(&(bar)[XB_TMO], 1u); break; } } } } while (0)
struct XcdBarrier { unsigned* bar; unsigned x; volatile LAS unsigned* st; };
__device__ __forceinline__ XcdBarrier xcd_barrier_post(unsigned* bar, volatile LAS unsigned* st) {
    XcdBarrier b; b.bar = bar; b.x = xb_xcc_id(); b.st = st;
    if (threadIdx.x == 0) (void)xb_add(&bar[XB_XCNT(b.x)], 1u);
    return b;
}
__device__ __forceinline__ void xcd_barrier_complete(unsigned* bar, unsigned x, unsigned& nloc, unsigned& nx) {
    const unsigned G = gridDim.x * gridDim.y * gridDim.z;
    unsigned sum, cnt, mine, sp = 0u;
    for (;;) {
        sum = 0u; cnt = 0u; mine = 0u;
#pragma unroll 1
        for (unsigned j = 0; j < 16; ++j) { const unsigned c = xb_ld(&bar[XB_XCNT(j)]); sum += c; cnt += (c > 0u) ? 1u : 0u; mine = (j == x) ? c : mine; }
        if (sum == G) break;
        __builtin_amdgcn_s_sleep(1);
        if ((++sp & 255u) == 0u) { if (xb_ld(&bar[XB_TMO])) break; if (sp > XB_SPIN_CAP) { atomicAdd(&bar[XB_TMO], 1u); break; } }
    }
    nloc = mine > 0u ? mine : 1u; nx = cnt > 0u ? cnt : 1u;
}
__device__ __forceinline__ void xcd_barrier(const XcdBarrier& b) {
    asm volatile("s_waitcnt vmcnt(0)" ::: "memory");
    __syncthreads();
    if (threadIdx.x == 0) {
        unsigned* bar = b.bar; asm volatile("" : "+s"(bar));
        __builtin_amdgcn_s_waitcnt(0);
        unsigned nloc = b.st[0], nx = b.st[1];
        if (nloc == 0u) { xcd_barrier_complete(bar, b.x, nloc, nx); b.st[0] = nloc; b.st[1] = nx; }
        const unsigned old = xb_add(&bar[XB_XSUB(b.x)], 1u);
        const unsigned gen = old / nloc;
        if (old + 1u == (gen + 1u) * nloc) {
            __builtin_amdgcn_fence(__ATOMIC_RELEASE, "agent");
            asm volatile("s_waitcnt vmcnt(0)" ::: "memory");
            const unsigned og = xb_add(&bar[XB_TOP], 1u);
            const unsigned tg = og / nx;
            if (og + 1u == (tg + 1u) * nx) xb_add(&bar[XB_TOPGEN], 1u);
            else XB_SPIN(xb_ld(&bar[XB_TOPGEN]) == tg, bar);
            __builtin_amdgcn_fence(__ATOMIC_ACQUIRE, "agent");
            xb_add(&bar[XB_XGEN(b.x)], 1u);
            asm volatile("s_waitcnt vmcnt(0)" ::: "memory");
        } else {
            XB_SPIN(xb_ld(&bar[XB_XGEN(b.x)]) == gen, bar);
            __builtin_amdgcn_fence(__ATOMIC_ACQUIRE, "agent");
            asm volatile("s_waitcnt vmcnt(0)" ::: "memory");
        }
    }
    __syncthreads();
}

struct StdOrder {
    int nM, nN, nwg, G, c; long a_tstep, b_tstep;
    __device__ void init(int Mr, int N, int G_, int c_, long at, long bt) { nM = Mr / 256; nN = N / 256; nwg = nM * nN; G = G_; c = c_; a_tstep = at; b_tstep = bt; }
    __device__ bool next(int i, pg8::Unit& u) const {
        const long L = (long)i * G + c; if (L >= nwg) return false;
        int wgid = (int)L; { const int q = nwg / pg8::NXCD, r = nwg % pg8::NXCD, xcd = wgid % pg8::NXCD, off = wgid / pg8::NXCD; wgid = (xcd < r ? xcd * (q + 1) : r * (q + 1) + (xcd - r) * q) + off; }
        const int nig = pg8::WGM * nN, gid = wgid / nig, fm = gid * pg8::WGM, gsz = (nM - fm) < pg8::WGM ? (nM - fm) : pg8::WGM;
        u.pm = fm + ((wgid % nig) % gsz); u.pn = (wgid % nig) / gsz; u.aoff = (long)u.pm * a_tstep; u.boff = (long)u.pn * b_tstep; return true;
    }
};
struct GroupOrder {
    int G, vcu; long a_gstep, a_tstep, b_gstep;
    __device__ bool next(int i, pg8::Unit& u) const {
        const int L = i * G + vcu; if (L >= 256) return false;
        u.pn = L >> 2; u.pm = L & 3; u.aoff = (long)u.pn * a_gstep + (long)u.pm * a_tstep; u.boff = (long)u.pn * b_gstep; return true;
    }
};

using pg8::f32x4; using pg8::Unit;
__device__ __forceinline__ v4u pack8(const f32x4& a, const f32x4& b) { v4u w; w.x = pg8::cvt_pk_bf16(a[0], a[1]); w.y = pg8::cvt_pk_bf16(a[2], a[3]); w.z = pg8::cvt_pk_bf16(b[0], b[1]); w.w = pg8::cvt_pk_bf16(b[2], b[3]); return w; }
__device__ __forceinline__ v2u pack4(const f32x4& a) { v2u w; w.x = pg8::cvt_pk_bf16(a[0], a[1]); w.y = pg8::cvt_pk_bf16(a[2], a[3]); return w; }

struct EpiS5In {
    static constexpr bool PERM = true, AFTER_DRAIN = false;
    bf16* Xcat; bf16* SZ;
    __device__ __forceinline__ void operator()(const f32x4 (&acc)[2][2][4][2], const Unit& u, int wr, int wc, int fr, int fq) const {
        const int row0 = u.pm * 256 + wr * 64 + fr;
#pragma unroll
        for (int ai = 0; ai < 2; ++ai)
#pragma unroll
            for (int m = 0; m < 4; ++m) { const int row = row0 + ai * 128 + m * 16;
#pragma unroll
                for (int bj = 0; bj < 2; ++bj) { const int col8 = u.pn * 256 + bj * 128 + wc * 32 + 8 * fq;
                    f32x4 v0 = acc[ai][bj][m][0], v1 = acc[ai][bj][m][1];
                    if (u.pn < 4) { const int g = col8 >> 4, h0 = col8 & 15;
                        *(v4u*)(Xcat + ((size_t)(g * 1024 + (row >> 4)) * 384 + (row & 15) * 16 + h0)) = pack8(v0, v1);
                    } else {
#pragma unroll
                        for (int e = 0; e < 4; ++e) { v0[e] = silu_f(v0[e]); v1[e] = silu_f(v1[e]); }
                        *(v4u*)(SZ + (size_t)row * 1024 + (col8 - 1024)) = pack8(v0, v1); } } }
    }
};
struct EpiDS {
    static constexpr bool PERM = false, AFTER_DRAIN = false;
    float* DS;
    __device__ __forceinline__ void operator()(const f32x4 (&acc)[2][2][4][2], const Unit& u, int wr, int wc, int fr, int fq) const {
        const int row0 = u.pm * 256 + wr * 64 + fr, col0 = wc * 32 + 4 * fq;
#pragma unroll
        for (int ai = 0; ai < 2; ++ai)
#pragma unroll
            for (int m = 0; m < 4; ++m) { float* rp = DS + ((size_t)u.pn * 1024 + row0 + ai * 128 + m * 16) * 128 + col0;
#pragma unroll
                for (int n = 0; n < 2; ++n) *(f32x4*)(rp + n * 16) = acc[ai][0][m][n]; }
    }
};
struct EpiS3 {
    static constexpr bool PERM = true, AFTER_DRAIN = false;
    bf16* Yg;
    __device__ __forceinline__ void operator()(const f32x4 (&acc)[2][2][4][2], const Unit& u, int wr, int wc, int fr, int fq) const {
        const int row0 = u.pm * 256 + wr * 64 + fr, col0 = wc * 32 + 8 * fq;
#pragma unroll
        for (int ai = 0; ai < 2; ++ai)
#pragma unroll
            for (int m = 0; m < 4; ++m) { bf16* rp = Yg + ((size_t)u.pn * 1024 + row0 + ai * 128 + m * 16) * 256 + col0;
#pragma unroll
                for (int bj = 0; bj < 2; ++bj) { f32x4 v0 = acc[ai][bj][m][0], v1 = acc[ai][bj][m][1];
#pragma unroll
                    for (int e = 0; e < 4; ++e) { v0[e] = gelu_tanh_f(v0[e]); v1[e] = gelu_tanh_f(v1[e]); }
                    *(v4u*)(rp + bj * 128) = pack8(v0, v1); } }
    }
};
struct EpiGlu {
    static constexpr bool PERM = true, AFTER_DRAIN = false;
    const bf16* Yg; const bf16* SZ; const float* bglu; bf16* Y2;
    __device__ __forceinline__ void operator()(const f32x4 (&acc)[2][2][4][2], const Unit& u, int wr, int wc, int fr, int fq) const {
        const int row0 = u.pm * 256 + wr * 64 + fr;
#pragma unroll
        for (int bj = 0; bj < 2; ++bj) { const int col8 = u.pn * 256 + bj * 128 + wc * 32 + 8 * fq;
            const f32x4 b0 = *(const f32x4*)(bglu + col8), b1 = *(const f32x4*)(bglu + col8 + 4);
#pragma unroll
            for (int ai = 0; ai < 2; ++ai)
#pragma unroll
                for (int m = 0; m < 4; ++m) { const int row = row0 + ai * 128 + m * 16;
                    const v4u yw = *(const v4u*)(Yg + ((size_t)(col8 >> 4) * M + row) * 16 + (col8 & 15));
                    const v4u zw = *(const v4u*)(SZ + (size_t)row * 1024 + col8);
                    f32x4 v0 = acc[ai][bj][m][0] + b0, v1 = acc[ai][bj][m][1] + b1;
                    v0[0] = bf_lo(yw.x) * sigmoid_f(v0[0]) * bf_lo(zw.x); v0[1] = bf_hi(yw.x) * sigmoid_f(v0[1]) * bf_hi(zw.x);
                    v0[2] = bf_lo(yw.y) * sigmoid_f(v0[2]) * bf_lo(zw.y); v0[3] = bf_hi(yw.y) * sigmoid_f(v0[3]) * bf_hi(zw.y);
                    v1[0] = bf_lo(yw.z) * sigmoid_f(v1[0]) * bf_lo(zw.z); v1[1] = bf_hi(yw.z) * sigmoid_f(v1[1]) * bf_hi(zw.z);
                    v1[2] = bf_lo(yw.w) * sigmoid_f(v1[2]) * bf_lo(zw.w); v1[3] = bf_hi(yw.w) * sigmoid_f(v1[3]) * bf_hi(zw.w);
                    *(v4u*)(Y2 + (size_t)row * 1024 + col8) = pack8(v0, v1); } }
    }
};
struct EpiF32 {
    static constexpr bool PERM = false, AFTER_DRAIN = false;
    float* C;
    __device__ __forceinline__ void operator()(const f32x4 (&acc)[2][2][4][2], const Unit& u, int wr, int wc, int fr, int fq) const {
        const int row0 = u.pm * 256 + wr * 64 + fr, col0 = u.pn * 256 + wc * 32 + 4 * fq;
#pragma unroll
        for (int ai = 0; ai < 2; ++ai)
#pragma unroll
            for (int m = 0; m < 4; ++m) { float* rowp = C + (size_t)(row0 + ai * 128 + m * 16) * 1024 + col0;
#pragma unroll
                for (int bj = 0; bj < 2; ++bj)
#pragma unroll
                    for (int n = 0; n < 2; ++n) *(f32x4*)(rowp + bj * 128 + n * 16) = acc[ai][bj][m][n]; }
    }
};
template <int CTRL> __device__ __forceinline__ float dpp_f(float x) { return __builtin_bit_cast(float, __builtin_amdgcn_update_dpp(0, __builtin_bit_cast(int, x), CTRL, 0xf, 0xf, true)); }
__device__ __forceinline__ float row_scan16(float x) { x += dpp_f<0x111>(x); x += dpp_f<0x112>(x); x += dpp_f<0x114>(x); x += dpp_f<0x118>(x); return x; }
__device__ __forceinline__ float row_last16(float x) { return swz_f<0x1f0>(x); }
struct EpiHgIn {
    static constexpr bool PERM = false, AFTER_DRAIN = false;
    const float* lb; bf16* Qt; bf16* Kt; bf16* Kh; bf16* V; bf16* SZ; float* E;
    __device__ __forceinline__ void operator()(const f32x4 (&acc)[2][2][4][2], const Unit& u, int wr, int wc, int fr, int fq) const {
        const int row0 = u.pm * 256 + wr * 64 + fr, ch = u.pn * 64 + wc * 16 + 4 * fq;
        const f32x4 lbv = *(const f32x4*)(lb + ch);
#pragma unroll
        for (int ai = 0; ai < 2; ++ai)
#pragma unroll
            for (int mp = 0; mp < 2; ++mp) { const int rowA = row0 + ai * 128 + mp * 32; const size_t offA = (size_t)rowA * 1024 + ch, offB = offA + 16 * 1024;
                const f32x4 qa = acc[ai][0][2 * mp][0], fza = acc[ai][0][2 * mp][1], va = acc[ai][1][2 * mp][0]; f32x4 za = acc[ai][1][2 * mp][1];
                const f32x4 qb = acc[ai][0][2 * mp + 1][0], fzb = acc[ai][0][2 * mp + 1][1], vb = acc[ai][1][2 * mp + 1][0]; f32x4 zb = acc[ai][1][2 * mp + 1][1];
                f32x4 qta, kta, kha, qtb, ktb, khb, ev;
#pragma unroll
                for (int e = 0; e < 4; ++e) { const float fa = lbv[e] + (1.f - lbv[e]) * sigmoid_f(fza[e]), fb = lbv[e] + (1.f - lbv[e]) * sigmoid_f(fzb[e]);
                    const float pa = row_scan16(__logf(fa)), ta = row_last16(pa), pb = ta + row_scan16(__logf(fb)), Bt = row_last16(pb);
                    const float ka = 1.f - fa, kb = 1.f - fb;
                    qta[e] = qa[e] * __expf(pa); kta[e] = ka * __expf(-pa); kha[e] = ka * __expf(Bt - pa);
                    qtb[e] = qb[e] * __expf(pb); ktb[e] = kb * __expf(-pb); khb[e] = kb * __expf(Bt - pb);
                    ev[e] = __expf(Bt); za[e] = silu_f(za[e]); zb[e] = silu_f(zb[e]); }
                *(v2u*)(Qt + offA) = pack4(qta); *(v2u*)(Kt + offA) = pack4(kta); *(v2u*)(Kh + offA) = pack4(kha); *(v2u*)(V + offA) = pack4(va); *(v2u*)(SZ + offA) = pack4(za);
                *(v2u*)(Qt + offB) = pack4(qtb); *(v2u*)(Kt + offB) = pack4(ktb); *(v2u*)(Kh + offB) = pack4(khb); *(v2u*)(V + offB) = pack4(vb); *(v2u*)(SZ + offB) = pack4(zb);
                if (fr == 0) *(f32x4*)(E + (size_t)(rowA >> 5) * 1024 + ch) = ev; }
    }
};
struct EpiAtIn {
    static constexpr bool PERM = false, AFTER_DRAIN = false;
    const float* bias; const float* cosT; const float* sinT; bf16* Q; bf16* Kk; bf16* V; bf16* SZ;
    __device__ __forceinline__ void operator()(const f32x4 (&acc)[2][2][4][2], const Unit& u, int wr, int wc, int fr, int fq) const {
        const int row0 = u.pm * 256 + wr * 64 + fr;
        if (u.pn <= 4) {
            const int hb = (u.pn < 4) ? (u.pn * 4 + wc) * 64 : 1024 + wc * 64;
            bf16* dst = (u.pn < 4) ? Q : Kk; const int ld = (u.pn < 4) ? 1024 : 256; const int cb = (u.pn < 4) ? u.pn * 256 : 0;
#pragma unroll
            for (int bj = 0; bj < 2; ++bj) { const int d1 = 16 * bj + 4 * fq;
                const f32x4 bia = *(const f32x4*)(bias + hb + d1), bib = *(const f32x4*)(bias + hb + d1 + 32);
#pragma unroll
                for (int ai = 0; ai < 2; ++ai)
#pragma unroll
                    for (int m = 0; m < 4; ++m) { const int row = row0 + ai * 128 + m * 16;
                        const f32x4 cs = *(const f32x4*)(cosT + (size_t)row * 32 + d1), sn = *(const f32x4*)(sinT + (size_t)row * 32 + d1);
                        const f32x4 t1 = acc[ai][bj][m][0] + bia, t2 = acc[ai][bj][m][1] + bib;
                        const f32x4 o1 = t1 * cs - t2 * sn, o2 = t2 * cs + t1 * sn;
                        bf16* rp = dst + (size_t)row * ld + cb + bj * 128 + wc * 32 + 4 * fq;
                        *(v2u*)(rp) = pack4(o1); *(v2u*)(rp + 16) = pack4(o2); } }
        } else {
#pragma unroll
            for (int bj = 0; bj < 2; ++bj)
#pragma unroll
                for (int n = 0; n < 2; ++n) { const int c = bj * 128 + wc * 32 + n * 16 + 4 * fq;
                    f32x4 bv = (f32x4){0.f, 0.f, 0.f, 0.f}; if (u.pn == 5) bv = *(const f32x4*)(bias + 1280 + c);
#pragma unroll
                    for (int ai = 0; ai < 2; ++ai)
#pragma unroll
                        for (int m = 0; m < 4; ++m) { const int row = row0 + ai * 128 + m * 16; f32x4 v = acc[ai][bj][m][n] + bv;
                            if (u.pn == 5) { *(v2u*)(V + (size_t)row * 256 + c) = pack4(v); }
                            else {
#pragma unroll
                                for (int e = 0; e < 4; ++e) v[e] = silu_f(v[e]);
                                *(v2u*)(SZ + (size_t)row * 1024 + (u.pn - 6) * 256 + c) = pack4(v); } } }
        }
    }
};

__device__ __forceinline__ int src_col(int mapkind, int n) {
    if (mapkind == 0) return n;
    const int pn = n >> 8, c = n & 255;
    if (mapkind == 1) { const int type = 2 * (c >> 7) + ((c >> 4) & 1), ch = 64 * pn + 16 * ((c >> 5) & 3) + (c & 15); return type * 1024 + ch; }
    const int d = 32 * ((c >> 4) & 1) + 16 * (c >> 7) + (c & 15), hl = (c >> 5) & 3;
    if (pn < 4) return (pn * 4 + hl) * 64 + d;
    if (pn == 4) return 1024 + hl * 64 + d;
    if (pn == 5) return 1280 + c;
    return 1536 + (pn - 6) * 256 + c;
}
__device__ __forceinline__ void transpose_item(const float* W, int K, int N, bf16* WT, int mapkind, LAS float* scr, int item, int lane) {
    const int nblk = N / 32, kb = item / nblk, nb = item % nblk, k0 = 64 * kb, n0 = 32 * nb;
    const int sc = src_col(mapkind, n0 + (lane & 31));
#pragma unroll 8
    for (int i = 0; i < 32; ++i) { const int kk = 2 * i + (lane >> 5); scr[kk * 33 + (lane & 31)] = W[(size_t)(k0 + kk) * N + sc]; }
    LDS_WAIT(); asm volatile("" ::: "memory");
    const int c = lane & 7;
#pragma unroll
    for (int j = 0; j < 4; ++j) { const int n = (lane >> 3) + 8 * j; const LAS float* s = scr + (8 * c) * 33 + n;
        v4u o; o.x = pk2(s[0 * 33], s[1 * 33]); o.y = pk2(s[2 * 33], s[3 * 33]); o.z = pk2(s[4 * 33], s[5 * 33]); o.w = pk2(s[6 * 33], s[7 * 33]);
        *(GAS v4u*)(WT + (size_t)(n0 + n) * K + k0 + 8 * c) = o; }
    LDS_WAIT(); asm volatile("" ::: "memory");
}
__device__ __forceinline__ void rms_row_to_bf16(const float* xrow, const float* g, bf16* orow, int lane) {
    const f32x4* xr = (const f32x4*)xrow + lane; const f32x4* gr = (const f32x4*)g + lane;
    f32x4 v[4]; float s = 0.f;
#pragma unroll
    for (int j = 0; j < 4; ++j) { v[j] = xr[64 * j]; s += (v[j].x * v[j].x + v[j].y * v[j].y) + (v[j].z * v[j].z + v[j].w * v[j].w); }
    const float rs = 1.f / sqrtf(wave_sum(s) * (1.f / 1024.f) + NORM_EPS);
    v2u* o8 = (v2u*)orow + lane;
#pragma unroll
    for (int j = 0; j < 4; ++j) { const f32x4 gg = gr[64 * j]; v2u w; w.x = pk2(v[j].x * rs * gg.x, v[j].y * rs * gg.y); w.y = pk2(v[j].z * rs * gg.z, v[j].w * rs * gg.w); o8[64 * j] = w; }
}
__device__ __forceinline__ void s5_build(int jg, const float* lam_re, const float* lam_im, const float* log_dt, const float* b_re, const float* b_im, const float* c_re, const float* c_im,
                                         const float* dskip, bf16* TV, bf16* WM, float* A16, LAS unsigned char* lds, int tid) {
    LAS float* PWr = (LAS float*)lds; LAS float* PWi = PWr + 17 * 64; LAS float* BBr = PWi + 17 * 64; LAS float* BBi = BBr + 1024; LAS float* CCr = BBi + 1024; LAS float* CCi = CCr + 1024; LAS float* KK = CCi + 1024;
    if (tid < 64) { const int p = tid; const float lr = lam_re[jg * 64 + p], li = lam_im[jg * 64 + p], dt = expf(log_dt[jg]);
        const float mag = expf(lr * dt), ar = mag * cosf(li * dt), ai = mag * sinf(li * dt), den = lr * lr + li * li;
        const float qr = ((ar - 1.f) * lr + ai * li) / den, qi = (ai * lr - (ar - 1.f) * li) / den;
        for (int h = 0; h < 16; ++h) { const float br = b_re[(jg * 64 + p) * 16 + h], bi = b_im[(jg * 64 + p) * 16 + h]; BBr[p * 16 + h] = qr * br - qi * bi; BBi[p * 16 + h] = qr * bi + qi * br; }
        float pr = 1.f, pi = 0.f;
        for (int k = 0; k <= 16; ++k) { PWr[k * 64 + p] = pr; PWi[k * 64 + p] = pi; const float nr = pr * ar - pi * ai, ni = pr * ai + pi * ar; pr = nr; pi = ni; }
        A16[(jg * 64 + p) * 2 + 0] = PWr[16 * 64 + p]; A16[(jg * 64 + p) * 2 + 1] = PWi[16 * 64 + p]; }
    for (int e = tid; e < 1024; e += 512) { CCr[e] = c_re[jg * 1024 + e]; CCi[e] = c_im[jg * 1024 + e]; }
    __syncthreads();
    for (int e = tid; e < 4096; e += 512) { const int k = e >> 8, ho = (e >> 4) & 15, hi = e & 15; float s = 0.f;
        for (int p = 0; p < 64; ++p) { const float cr = CCr[ho * 64 + p], ci = CCi[ho * 64 + p], wr_ = PWr[k * 64 + p], wi_ = PWi[k * 64 + p];
            const float xr = cr * wr_ - ci * wi_, xi = cr * wi_ + ci * wr_; s += xr * BBr[p * 16 + hi] - xi * BBi[p * 16 + hi]; }
        if (k == 0 && ho == hi) s += dskip[(jg >> 6) * 1024 + (jg & 63) * 16 + ho];
        KK[e] = s; }
    __syncthreads();
    const int g = jg & 63;
    bf16* tv = TV + (size_t)g * 256 * 384;
    for (int e = tid; e < 256 * 384; e += 512) { const int n = e / 384, kk = e - n * 384, jj = n >> 4, ho = n & 15; float val;
        if (kk < 256) { const int i = kk >> 4, hi = kk & 15; val = (i <= jj) ? KK[(jj - i) * 256 + ho * 16 + hi] : 0.f; }
        else if (kk < 320) { const int p = kk - 256; val = CCr[ho * 64 + p] * PWr[(jj + 1) * 64 + p] - CCi[ho * 64 + p] * PWi[(jj + 1) * 64 + p]; }
        else { const int p = kk - 320; val = -(CCr[ho * 64 + p] * PWi[(jj + 1) * 64 + p] + CCi[ho * 64 + p] * PWr[(jj + 1) * 64 + p]); }
        tv[e] = (bf16)f2bf(val); }
    bf16* wm = WM + (size_t)g * 128 * 256;
    for (int e = tid; e < 128 * 256; e += 512) { const int n = e >> 8, kk = e & 255, i = kk >> 4, hi = kk & 15, p = n & 63, pw = 15 - i;
        const float re = PWr[pw * 64 + p] * BBr[p * 16 + hi] - PWi[pw * 64 + p] * BBi[p * 16 + hi], im = PWr[pw * 64 + p] * BBi[p * 16 + hi] + PWi[pw * 64 + p] * BBr[p * 16 + hi];
        wm[e] = (bf16)f2bf(n < 64 ? re : im); }
    __syncthreads();
}


typedef float f32x16 __attribute__((ext_vector_type(16)));
typedef short s16x4 __attribute__((ext_vector_type(4)));
typedef short bf16x8v __attribute__((ext_vector_type(8)));
__device__ __forceinline__ int crow16(int i, int h) { return (i & 3) + 8 * (i >> 2) + 4 * h; }
__device__ __forceinline__ unsigned cvtpk(float lo, float hi) { typedef float f2 __attribute__((ext_vector_type(2))); typedef __bf16 b2 __attribute__((ext_vector_type(2))); f2 v = {lo, hi}; b2 b = __builtin_convertvector(v, b2); return __builtin_bit_cast(unsigned, b); }
__device__ __forceinline__ bf16x8v pack_frag(const f32x16& x, int s) { v4u p; p.x = cvtpk(x[8 * s], x[8 * s + 1]); p.y = cvtpk(x[8 * s + 2], x[8 * s + 3]); p.z = cvtpk(x[8 * s + 4], x[8 * s + 5]); p.w = cvtpk(x[8 * s + 6], x[8 * s + 7]); return __builtin_bit_cast(bf16x8v, p); }
__device__ __forceinline__ s16x4 tr_read16(const LAS unsigned char* p) { typedef short v4i16_t __attribute__((ext_vector_type(4))); return __builtin_bit_cast(s16x4, __builtin_amdgcn_ds_read_tr16_b64_v4i16((LAS v4i16_t*)p)); }
__device__ __forceinline__ float half_max(float v) { const unsigned u = __builtin_bit_cast(unsigned, v); auto r = __builtin_amdgcn_permlane32_swap(u, u, false, false); return fmaxf(__builtin_bit_cast(float, (unsigned)r[0]), __builtin_bit_cast(float, (unsigned)r[1])); }
constexpr int AT_KPITCH = 144, AT_K_OFF = 0, AT_V_OFF = 256 * AT_KPITCH, AT_WS_OFF = AT_V_OFF + 2 * 256 * 64;
__device__ __forceinline__ void attn_phase(LAS unsigned char* lds, const bf16* Qa, const bf16* Ka, const bf16* Va, const bf16* SZ, bf16* Y2, const float* sinks, int G, int vcu) {
    const int tid = TID, lane = tid & 63, wave = __builtin_amdgcn_readfirstlane(tid >> 6), r = lane & 31, h = lane >> 5;
    LAS float* wsf = (LAS float*)(lds + AT_WS_OFF) + wave * 64;
    const float C2 = 0.125f * 1.4426950408889634f, L2E = 1.4426950408889634f;
    const int trq = (lane & 15) >> 2, trp = lane & 3, trblk = (lane >> 4) & 1;
#pragma unroll 1
    for (int unit = vcu; unit < 512; unit += G) {
        const int b = unit >> 8, n = (unit >> 2) & 63, hk = unit & 3;
        const int key0 = 128 * (n - 1);
        __syncthreads();
#pragma unroll
        for (int k = 0; k < 4; ++k) { const int c = tid + 512 * k, key = c >> 3, ch = c & 7, gk = key0 + key;
            v4u kv = (v4u){0u, 0u, 0u, 0u}, vv = (v4u){0u, 0u, 0u, 0u};
            if (gk >= 0) { const size_t rb = ((size_t)b * SEQ + gk) * 256;
                kv = *(const v4u*)(Ka + rb + ((ch < 4) ? 32 * hk + 8 * ch : 128 + 32 * hk + 8 * (ch - 4)));
                vv = *(const v4u*)(Va + rb + hk * 64 + 8 * ch); }
            *(LAS v4u*)(lds + AT_K_OFF + key * AT_KPITCH + ch * 16) = kv;
            *(LAS v4u*)(lds + AT_V_OFF + (ch >> 2) * 16384 + key * 64 + (ch & 3) * 16) = vv; }
        __syncthreads();
#pragma unroll 1
        for (int tt = 0; tt < 2; ++tt) {
            const int task = 2 * wave + tt, g = task >> 2, qi = task & 3, hq = hk * 4 + g;
            const size_t qrow0 = (size_t)b * SEQ + 128 * n + 32 * qi;
            bf16x8v qf[4];
            { const bf16* qb = Qa + (qrow0 + r) * 1024 + (hq >> 2) * 256 + (hq & 3) * 32 + 8 * h;
#pragma unroll
              for (int s = 0; s < 4; ++s) qf[s] = *(const bf16x8v*)(qb + (s >> 1) * 128 + (s & 1) * 16); }
            f32x16 p[5];
#pragma unroll
            for (int T = 0; T < 5; ++T) { f32x16 acc;
#pragma unroll
                for (int i = 0; i < 16; ++i) acc[i] = 0.f;
                const LAS unsigned char* kp = lds + AT_K_OFF + (32 * (qi + T) + r) * AT_KPITCH + h * 16;
#pragma unroll
                for (int s = 0; s < 4; ++s) { const bf16x8v kf = *(const LAS bf16x8v*)(kp + s * 32); acc = __builtin_amdgcn_mfma_f32_32x32x16_bf16(kf, qf[s], acc, 0, 0, 0); }
                p[T] = acc; }
            const bool first = (n == 0);
            float mx = -INFINITY;
#pragma unroll
            for (int T = 0; T < 5; ++T)
#pragma unroll
                for (int i = 0; i < 16; ++i) { const int cr = crow16(i, h); bool valid = true;
                    if (T == 0) valid = cr > r; if (T == 4) valid = cr <= r;
                    if (first && (qi + T) < 4) valid = false;
                    const float t = valid ? p[T][i] * C2 : -INFINITY; p[T][i] = t; mx = fmaxf(mx, t); }
            mx = half_max(mx);
            const float sk = sinks[hq] * L2E, m2 = fmaxf(mx, sk);
            float ls = 0.f;
#pragma unroll
            for (int T = 0; T < 5; ++T)
#pragma unroll
                for (int i = 0; i < 16; ++i) { const float e = __builtin_amdgcn_exp2f(p[T][i] - m2); p[T][i] = e; ls += e; }
            ls = xor_sum_32(ls) + __builtin_amdgcn_exp2f(sk - m2);
            if (h == 0) wsf[r] = 1.f / ls;
            f32x16 o0, o1;
#pragma unroll
            for (int i = 0; i < 16; ++i) { o0[i] = 0.f; o1[i] = 0.f; }
#pragma unroll
            for (int T = 0; T < 5; ++T)
#pragma unroll
                for (int s = 0; s < 2; ++s) { const bf16x8v pa = pack_frag(p[T], s);
                    const LAS unsigned char* vp = lds + AT_V_OFF + (32 * (qi + T) + 16 * s + 4 * h + trq) * 64 + (16 * trblk + 4 * trp) * 2;
                    const s16x4 l0 = tr_read16(vp), h0 = tr_read16(vp + 8 * 64), l1 = tr_read16(vp + 16384), h1 = tr_read16(vp + 16384 + 8 * 64);
                    const bf16x8v v0 = __builtin_shufflevector(l0, h0, 0, 1, 2, 3, 4, 5, 6, 7), v1 = __builtin_shufflevector(l1, h1, 0, 1, 2, 3, 4, 5, 6, 7);
                    o0 = __builtin_amdgcn_mfma_f32_32x32x16_bf16(pa, v0, o0, 0, 0, 0); o1 = __builtin_amdgcn_mfma_f32_32x32x16_bf16(pa, v1, o1, 0, 0, 0); }
            LDS_WAIT();
#pragma unroll
            for (int i = 0; i < 16; ++i) { const int cr = crow16(i, h); const float li = wsf[cr]; const size_t off = (qrow0 + cr) * 1024 + hq * 64 + r;
                Y2[off] = (bf16)f2bf(o0[i] * li * bf2f(SZ[off])); Y2[off + 32] = (bf16)f2bf(o1[i] * li * bf2f(SZ[off + 32])); }
        }
    }
    __syncthreads();
}


constexpr int HG_QT = 0, HG_KT = 8704, HG_KH = 17408, HG_VV = 27648, HG_EE = 37888, HG_RED = 38400, HG_HALF = 39936, HG_QP = 272, HG_KP = 320;
template <bool FULL>
__device__ __forceinline__ void hg_phase(LAS unsigned char* lds0, const bf16* Qt, const bf16* Kt, const bf16* Kh, const bf16* V, const bf16* SZ, const float* E, float* ST, float* DD, const float* gn, bf16* Y2, int G, int vcu) {
    const int tid = TID, lane = tid & 63, wave = __builtin_amdgcn_readfirstlane(tid >> 6), half = wave >> 2, w = wave & 3, lt = tid & 255, r = lane & 31, h = lane >> 5;
    LAS unsigned char* lds = lds0 + half * HG_HALF;
    const int trq = (lane & 15) >> 2, trp = lane & 3, trblk = (lane >> 4) & 1;
    const int c0row = lt >> 4, c0ch = lt & 15;
#pragma unroll 1
    for (int pu = vcu; pu < 256; pu += G) {
        const int unit = 2 * pu + half, bh = unit >> 5, c = unit & 31, hd = bh & 7;
        const size_t rowbase = (size_t)(bh >> 3) * SEQ + (size_t)c * 256;
        float* st = ST + (size_t)unit * 16384;
        f32x16 S[4];
        if (FULL) {
#pragma unroll
            for (int kt = 0; kt < 4; ++kt)
#pragma unroll
                for (int i = 0; i < 16; ++i) S[kt][i] = st[(32 * kt + crow16(i, h)) * 128 + 32 * w + r];
        } else {
#pragma unroll
            for (int kt = 0; kt < 4; ++kt)
#pragma unroll
                for (int i = 0; i < 16; ++i) S[kt][i] = 0.f;
        }
        float dacc = 1.f;
        v4u pq[2], pk[2], ph[2], pv[2]; f32x4 pe = (f32x4){0.f, 0.f, 0.f, 0.f};
        { const size_t g0 = (rowbase + c0row) * 1024 + hd * 128 + c0ch * 8;
#pragma unroll
          for (int k2 = 0; k2 < 2; ++k2) { const size_t go = g0 + (size_t)k2 * 16 * 1024; if (FULL) { pq[k2] = *(const v4u*)(Qt + go); pk[k2] = *(const v4u*)(Kt + go); } ph[k2] = *(const v4u*)(Kh + go); pv[k2] = *(const v4u*)(V + go); }
          if (lt < 32) pe = *(const f32x4*)(E + (rowbase >> 5) * 1024 + hd * 128 + lt * 4); }
#pragma unroll 1
        for (int I = 0; I < 8; ++I) {
#pragma unroll
            for (int k2 = 0; k2 < 2; ++k2) { const int row = c0row + 16 * k2;
                if (FULL) { *(LAS v4u*)(lds + HG_QT + row * HG_QP + c0ch * 16) = pq[k2]; *(LAS v4u*)(lds + HG_KT + row * HG_QP + c0ch * 16) = pk[k2]; }
                *(LAS v4u*)(lds + HG_KH + row * HG_KP + c0ch * 16) = ph[k2]; *(LAS v4u*)(lds + HG_VV + row * HG_KP + c0ch * 16) = pv[k2]; }
            if (lt < 32) *(LAS f32x4*)(lds + HG_EE + lt * 16) = pe;
            __syncthreads();
            if (I + 1 < 8) { const size_t g0 = (rowbase + 32 * (I + 1) + c0row) * 1024 + hd * 128 + c0ch * 8;
#pragma unroll
                for (int k2 = 0; k2 < 2; ++k2) { const size_t go = g0 + (size_t)k2 * 16 * 1024; if (FULL) { pq[k2] = *(const v4u*)(Qt + go); pk[k2] = *(const v4u*)(Kt + go); } ph[k2] = *(const v4u*)(Kh + go); pv[k2] = *(const v4u*)(V + go); }
                if (lt < 32) pe = *(const f32x4*)(E + ((rowbase >> 5) + I + 1) * 1024 + hd * 128 + lt * 4); }
            f32x16 oT;
            if (FULL) {
                f32x16 x2;
#pragma unroll
                for (int i = 0; i < 16; ++i) x2[i] = 0.f;
#pragma unroll
                for (int kk = 0; kk < 8; ++kk) { const bf16x8v kf = *(const LAS bf16x8v*)(lds + HG_KT + r * HG_QP + (16 * kk + 8 * h) * 2), qf = *(const LAS bf16x8v*)(lds + HG_QT + r * HG_QP + (16 * kk + 8 * h) * 2);
                    x2 = __builtin_amdgcn_mfma_f32_32x32x16_bf16(kf, qf, x2, 0, 0, 0); }
#pragma unroll
                for (int i = 0; i < 16; ++i) x2[i] = (crow16(i, h) <= r) ? x2[i] : 0.f;
#pragma unroll
                for (int i = 0; i < 16; ++i) oT[i] = 0.f;
#pragma unroll
                for (int s2 = 0; s2 < 2; ++s2) { const bf16x8v xf = pack_frag(x2, s2);
                    const LAS unsigned char* vp = lds + HG_VV + (16 * s2 + 4 * h + trq) * HG_KP + (32 * w + 16 * trblk + 4 * trp) * 2;
                    const s16x4 lo = tr_read16(vp), hi = tr_read16(vp + 8 * HG_KP);
                    const bf16x8v vf = __builtin_shufflevector(lo, hi, 0, 1, 2, 3, 4, 5, 6, 7);
                    oT = __builtin_amdgcn_mfma_f32_32x32x16_bf16(vf, xf, oT, 0, 0, 0); }
#pragma unroll
                for (int kt = 0; kt < 4; ++kt)
#pragma unroll
                    for (int s2 = 0; s2 < 2; ++s2) { const bf16x8v sf = pack_frag(S[kt], s2);
                        const LAS unsigned char* qp = lds + HG_QT + r * HG_QP + (32 * kt + 16 * s2 + 4 * h) * 2;
                        const s16x4 lo = *(const LAS s16x4*)qp, hi = *(const LAS s16x4*)(qp + 16);
                        const bf16x8v qf = __builtin_shufflevector(lo, hi, 0, 1, 2, 3, 4, 5, 6, 7);
                        oT = __builtin_amdgcn_mfma_f32_32x32x16_bf16(sf, qf, oT, 0, 0, 0); }
            }
#pragma unroll
            for (int kt = 0; kt < 4; ++kt) {
#pragma unroll
                for (int g4 = 0; g4 < 4; ++g4) { const f32x4 ev = *(const LAS f32x4*)(lds + HG_EE + (32 * kt + 8 * g4 + 4 * h) * 4);
#pragma unroll
                    for (int e = 0; e < 4; ++e) S[kt][4 * g4 + e] *= ev[e]; }
#pragma unroll
                for (int s2 = 0; s2 < 2; ++s2) {
                    const LAS unsigned char* kp = lds + HG_KH + (16 * s2 + 8 * h + trq) * HG_KP + (32 * kt + 16 * trblk + 4 * trp) * 2;
                    const LAS unsigned char* vp = lds + HG_VV + (16 * s2 + 8 * h + trq) * HG_KP + (32 * w + 16 * trblk + 4 * trp) * 2;
                    const s16x4 kl = tr_read16(kp), kh = tr_read16(kp + 4 * HG_KP), vl = tr_read16(vp), vh = tr_read16(vp + 4 * HG_KP);
                    const bf16x8v kf = __builtin_shufflevector(kl, kh, 0, 1, 2, 3, 4, 5, 6, 7), vf = __builtin_shufflevector(vl, vh, 0, 1, 2, 3, 4, 5, 6, 7);
                    S[kt] = __builtin_amdgcn_mfma_f32_32x32x16_bf16(kf, vf, S[kt], 0, 0, 0); } }
            if (FULL) {
                float ss = 0.f;
#pragma unroll
                for (int i = 0; i < 16; ++i) ss += oT[i] * oT[i];
                ss = xor_sum_32(ss);
                if (h == 0) *(LAS float*)(lds + HG_RED + (w * 32 + r) * 4) = ss;
            } else {
                if (lt < 128) dacc *= *(const LAS float*)(lds + HG_EE + lt * 4);
            }
            __syncthreads();
            if (FULL) {
                const float tot = *(const LAS float*)(lds + HG_RED + r * 4) + *(const LAS float*)(lds + HG_RED + (32 + r) * 4) + *(const LAS float*)(lds + HG_RED + (64 + r) * 4) + *(const LAS float*)(lds + HG_RED + (96 + r) * 4);
                const float rs = 1.f / sqrtf(tot * (1.f / 128.f) + NORM_EPS);
                const size_t ob = (rowbase + 32 * I + r) * 1024 + hd * 128 + 32 * w + 4 * h;
#pragma unroll
                for (int g4 = 0; g4 < 4; ++g4) { const v2u zw = *(const v2u*)(SZ + ob + 8 * g4); const f32x4 gv = *(const f32x4*)(gn + hd * 128 + 32 * w + 4 * h + 8 * g4);
                    v2u ow; ow.x = cvtpk(oT[4 * g4] * rs * gv[0] * bf_lo(zw.x), oT[4 * g4 + 1] * rs * gv[1] * bf_hi(zw.x)); ow.y = cvtpk(oT[4 * g4 + 2] * rs * gv[2] * bf_lo(zw.y), oT[4 * g4 + 3] * rs * gv[3] * bf_hi(zw.y));
                    *(v2u*)(Y2 + ob + 8 * g4) = ow; }
            }
        }
        if (!FULL) {
#pragma unroll
            for (int kt = 0; kt < 4; ++kt)
#pragma unroll
                for (int i = 0; i < 16; ++i) st[(32 * kt + crow16(i, h)) * 128 + 32 * w + r] = S[kt][i];
            if (lt < 128) DD[(size_t)unit * 128 + lt] = dacc;
        }
    }
    __syncthreads();
}
__device__ __forceinline__ void hg_scan(float* ST, const float* DD, int G, int bx) {
    const int nthr = G * 512;
#pragma unroll 1
    for (int e0 = bx * 512 + TID; e0 < 16 * 16384; e0 += nthr) { const int bh = e0 >> 14, e = e0 & 16383, k = e >> 7;
        float S = 0.f;
#pragma unroll 1
        for (int c0 = 0; c0 < 32; c0 += 8) { float a[8], d[8];
#pragma unroll
            for (int j = 0; j < 8; ++j) { a[j] = ST[((size_t)(bh * 32 + c0 + j)) * 16384 + e]; d[j] = DD[(size_t)(bh * 32 + c0 + j) * 128 + k]; }
#pragma unroll
            for (int j = 0; j < 8; ++j) { ST[((size_t)(bh * 32 + c0 + j)) * 16384 + e] = S; S = d[j] * S + a[j]; } }
    }
}

struct Args { const void* in[24]; float* out; unsigned char* ws; int ph_lo, ph_hi; };
constexpr int PT_OFF = LDSCTL_OFF + 1024;
enum { I_X = 0, I_POS, I_NPRE, I_NPOST, I_S5WIN, I_S5LRE, I_S5LIM, I_S5LDT, I_S5BRE, I_S5BIM, I_S5CRE, I_S5CIM, I_S5D, I_S5WGLU, I_S5BGLU, I_S5WOUT, I_HGWIN, I_HGLBL, I_HGNORM, I_HGWOUT, I_ATWIN, I_ATBIN, I_ATSINK, I_ATWOUT, I_OUT, I_WS };
__device__ __forceinline__ unsigned char* gptr(LAS unsigned char* lds, int k) {
    unsigned off = PT_OFF + 8 * k; asm volatile("" : "+v"(off));
    const volatile LAS unsigned* t = (const volatile LAS unsigned*)(lds + off);
    const unsigned lo = __builtin_amdgcn_readfirstlane(t[0]), hi = __builtin_amdgcn_readfirstlane(t[1]);
    return (unsigned char*)(((unsigned long long)hi << 32) | lo);
}
#define VOFF_ROWMAJOR(v, ld, perm) do { int tq_ = threadIdx.x; asm volatile("" : "+v"(tq_)); int R_, C_; pg8::stage_rc(tq_ * 16, R_, C_); if (perm) R_ = (R_ & ~31) + pg8::perm32(R_ & 31); (v) = (unsigned)(R_ * (ld) + C_) * 2u; } while (0)

__global__ void __launch_bounds__(NWAVES * 64, 2) mk_fwd(Args args) {
    extern __shared__ __attribute__((aligned(16))) unsigned char lds_raw[];
    LAS unsigned char* lds = (LAS unsigned char*)lds_raw;
    volatile LAS unsigned* MISC = (volatile LAS unsigned*)(lds + MISC_OFF);
    for (int u = threadIdx.x; u < (LDS_BYTES - LDSCTL_OFF) / 4; u += NWAVES * 64) ((LAS unsigned*)(lds + LDSCTL_OFF))[u] = 0u;
    __syncthreads();
    if (threadIdx.x == 0) { volatile LAS unsigned long long* t = (volatile LAS unsigned long long*)(lds + PT_OFF);
#pragma unroll
        for (int k = 0; k < 24; ++k) t[k] = (unsigned long long)args.in[k];
        t[I_OUT] = (unsigned long long)args.out; t[I_WS] = (unsigned long long)args.ws; }
    __syncthreads();
    const int lo = args.ph_lo, hi = args.ph_hi;
    XcdBarrier bar = xcd_barrier_post((unsigned*)(gptr(lds, I_WS) + WS_CTL) + CW_BAR, MISC + 8);
    enum { OP_PRO = 0, OP_S5IN, OP_S1, OP_S2, OP_S3, OP_GLU, OP_HGIN, OP_HG1, OP_HG2, OP_HG3, OP_ATIN, OP_ATT, OP_OUT, OP_NORM };

#pragma unroll 1
    for (int ph = lo; ph < hi; ++ph) {
    int layer, sub;
    if (ph < 8) { layer = 0; sub = ph - 1; } else if (ph < 14) { layer = 1; sub = ph - 8; } else if (ph < 18) { layer = 2; sub = ph - 14; } else { layer = 3; sub = ph - 18; }
    const int kind = layer % 3, jj = layer / 3;
    int op;
    if (ph == 0) op = OP_PRO;
    else if (kind == 0) op = (sub < 5) ? OP_S5IN + sub : (sub == 5 ? OP_OUT : OP_NORM);
    else if (kind == 1) op = (sub < 4) ? OP_HGIN + sub : (sub == 4 ? OP_OUT : OP_NORM);
    else op = (sub < 2) ? OP_ATIN + sub : (sub == 2 ? OP_OUT : OP_NORM);
    if (op == OP_PRO) {
        unsigned char* ws = gptr(lds, I_WS);
        const int lane = LANE, wave = WAVE, gw = GW, ngw = NGW;
        LAS float* scr = (LAS float*)(lds + RING_OFF + wave * 16384);
        int base = 0;
#define DO_W(idx_, soff_, K_, N_, dst_, map_) do { const float* Wp_ = (const float*)gptr(lds, idx_) + (size_t)(soff_); const int nit = ((K_) / 64) * ((N_) / 32); int first = gw - (base % ngw); if (first < 0) first += ngw; \
            for (int it = first; it < nit; it += ngw) transpose_item(Wp_, (K_), (N_), (bf16*)(ws + (dst_)), (map_), scr, it, lane); base += nit; } while (0)
        DO_W(I_S5WIN, 0, 1024, 2048, WS_W_S5IN0, 0); DO_W(I_S5WIN, 1024 * 2048, 1024, 2048, WS_W_S5IN1, 0);
        DO_W(I_S5WGLU, 0, 1024, 1024, WS_W_S5GLU0, 0); DO_W(I_S5WGLU, 1024 * 1024, 1024, 1024, WS_W_S5GLU1, 0);
        DO_W(I_S5WOUT, 0, 1024, 1024, WS_W_S5OUT0, 0); DO_W(I_S5WOUT, 1024 * 1024, 1024, 1024, WS_W_S5OUT1, 0);
        DO_W(I_HGWIN, 0, 1024, 4096, WS_W_HGIN, 1); DO_W(I_HGWOUT, 0, 1024, 1024, WS_W_HGOUT, 0);
        DO_W(I_ATWIN, 0, 1024, 2560, WS_W_ATIN, 2); DO_W(I_ATWOUT, 0, 1024, 1024, WS_W_ATOUT, 0);
#undef DO_W
        { const float* x = (const float*)gptr(lds, I_X); const float* npre = (const float*)gptr(lds, I_NPRE); bf16* XN = (bf16*)(ws + A_XN);
          for (int m = gw; m < M; m += ngw) rms_row_to_bf16(x + (size_t)m * DM, npre, XN + (size_t)m * DM, lane); }
        { const int* positions = (const int*)gptr(lds, I_POS); float* cosT = (float*)(ws + WS_ROPE); float* sinT = cosT + (size_t)M * 32;
          for (int e = BX * 512 + TID; e < M * 32; e += GRID * 512) { const int r = e >> 5, i = e & 31;
            const float inv = powf(10000.f, -(float)(2 * i) / 64.f); const float ang = (float)positions[r] * inv; cosT[e] = cosf(ang); sinT[e] = sinf(ang); } }
        { const float* hg_lbl = (const float*)gptr(lds, I_HGLBL); float* lbv = (float*)(ws + WS_MISC + MISC_LB);
          for (int c = BX * 512 + TID; c < 1024; c += GRID * 512) { const float l0 = hg_lbl[c], l1 = hg_lbl[1024 + c], l2 = hg_lbl[2048 + c], l3 = hg_lbl[3072 + c];
            const float mx = fmaxf(fmaxf(l0, l1), fmaxf(l2, l3)); const float e0 = expf(l0 - mx), e1 = expf(l1 - mx), e2 = expf(l2 - mx), e3 = expf(l3 - mx); lbv[c] = e1 / (e0 + e1 + e2 + e3); } }
        __syncthreads();
        for (int jg = VCU; jg < 128; jg += GRID) { const int j = jg >> 6;
            s5_build(jg, (const float*)gptr(lds, I_S5LRE), (const float*)gptr(lds, I_S5LIM), (const float*)gptr(lds, I_S5LDT), (const float*)gptr(lds, I_S5BRE), (const float*)gptr(lds, I_S5BIM),
                     (const float*)gptr(lds, I_S5CRE), (const float*)gptr(lds, I_S5CIM), (const float*)gptr(lds, I_S5D), (bf16*)(ws + (j ? WS_TV1 : WS_TV0)), (bf16*)(ws + (j ? WS_WM1 : WS_WM0)),
                     (float*)(ws + WS_MISC + MISC_A16), lds, TID); }
        __syncthreads();
    }

            else if (op == OP_S5IN) {
                unsigned char* ws = gptr(lds, I_WS);
                unsigned vA, vB; VOFF_ROWMAJOR(vA, 1024, false); VOFF_ROWMAJOR(vB, 1024, true);
                pg8::Gemm g{(const char*)(ws + A_XN), (const char*)(ws + (jj ? WS_W_S5IN1 : WS_W_S5IN0))};
                StdOrder S; S.init(M, 2048, GRID, BX, 256 * 1024 * 2, 256 * 1024 * 2);
                EpiS5In E{(bf16*)(ws + A_XCAT), (bf16*)(ws + A_SZ_S5)};
                pg8::gemm_phase<pg8::Cfg<128, 128 * 1024 * 2, 128, 128 * 1024 * 2, 16>, EpiS5In, StdOrder, true, true>(lds + RING_OFF, g, vA, vB, S, E);
            }
            else if (op == OP_S1) {
                unsigned char* ws = gptr(lds, I_WS);
                unsigned vA, vB; VOFF_ROWMAJOR(vA, 384, false); VOFF_ROWMAJOR(vB, 256, false);
                pg8::Gemm g{(const char*)(ws + A_XCAT), (const char*)(ws + (jj ? WS_WM1 : WS_WM0))};
                GroupOrder S{GRID, VCU, (long)1024 * 384 * 2, (long)256 * 384 * 2, (long)128 * 256 * 2};
                EpiDS E{(float*)(ws + A_DS)};
                pg8::gemm_phase<pg8::Cfg<128, 128 * 384 * 2, 128, 0, 4>, EpiDS, GroupOrder, true, true>(lds + RING_OFF, g, vA, vB, S, E);
            }
            else if (op == OP_S2) {
                if (WAVE == 0) {
                    unsigned char* ws = gptr(lds, I_WS); const float* A16 = (const float*)(ws + WS_MISC + MISC_A16); const float* DS = (const float*)(ws + A_DS); bf16* Xcat = (bf16*)(ws + A_XCAT);
                    for (int bg = VCU; bg < 128; bg += GRID) { const int b = bg >> 6, g = bg & 63, p = LANE;
                        const float ar = A16[((jj * 64 + g) * 64 + p) * 2], ai = A16[((jj * 64 + g) * 64 + p) * 2 + 1];
                        float sr = 0.f, si = 0.f; const size_t rb = (size_t)g * 1024 + (size_t)b * 512;
                        for (int c0 = 0; c0 < 512; c0 += 8) { float dr[8], di[8];
#pragma unroll
                            for (int k = 0; k < 8; ++k) { dr[k] = DS[(rb + c0 + k) * 128 + p]; di[k] = DS[(rb + c0 + k) * 128 + 64 + p]; }
#pragma unroll
                            for (int k = 0; k < 8; ++k) { bf16* xr = Xcat + (rb + c0 + k) * 384 + 256; xr[p] = (bf16)f2bf(sr); xr[64 + p] = (bf16)f2bf(si);
                                const float nr = ar * sr - ai * si + dr[k], ni = ar * si + ai * sr + di[k]; sr = nr; si = ni; } } }
                }
            }
            else if (op == OP_S3) {
                unsigned char* ws = gptr(lds, I_WS);
                unsigned vA, vB; VOFF_ROWMAJOR(vA, 384, false); VOFF_ROWMAJOR(vB, 384, true);
                pg8::Gemm g{(const char*)(ws + A_XCAT), (const char*)(ws + (jj ? WS_TV1 : WS_TV0))};
                GroupOrder S{GRID, VCU, (long)1024 * 384 * 2, (long)256 * 384 * 2, (long)256 * 384 * 2};
                EpiS3 E{(bf16*)(ws + A_YG)};
                pg8::gemm_phase<pg8::Cfg<128, 128 * 384 * 2, 128, 128 * 384 * 2, 6>, EpiS3, GroupOrder, true, true>(lds + RING_OFF, g, vA, vB, S, E);
            }
            else if (op == OP_GLU) {
                unsigned char* ws = gptr(lds, I_WS);
                unsigned vA, vB; VOFF_ROWMAJOR(vB, 1024, true);
                { int tq_ = threadIdx.x; asm volatile("" : "+v"(tq_)); int R_, C_; pg8::stage_rc(tq_ * 16, R_, C_); vA = (unsigned)(((C_ >> 4) * M + R_) * 16 + (C_ & 15)) * 2u; }
                pg8::Gemm g{(const char*)(ws + A_YG), (const char*)(ws + (jj ? WS_W_S5GLU1 : WS_W_S5GLU0))};
                StdOrder S; S.init(M, 1024, GRID, BX, 256 * 16 * 2, 256 * 1024 * 2);
                EpiGlu E{(const bf16*)(ws + A_YG), (const bf16*)(ws + A_SZ_S5), (const float*)gptr(lds, I_S5BGLU) + jj * 1024, (bf16*)(ws + A_Y2_S5)};
                pg8::gemm_phase<pg8::Cfg<(long)4 * M * 16 * 2, 128 * 16 * 2, 128, 128 * 1024 * 2, 16>, EpiGlu, StdOrder, true, true>(lds + RING_OFF, g, vA, vB, S, E);
            }
            else if (op == OP_HGIN) {
                unsigned char* ws = gptr(lds, I_WS);
                unsigned vA, vB; VOFF_ROWMAJOR(vA, 1024, false); VOFF_ROWMAJOR(vB, 1024, false);
                pg8::Gemm g{(const char*)(ws + A_XN_HG), (const char*)(ws + WS_W_HGIN)};
                StdOrder S; S.init(M, 4096, GRID, BX, 256 * 1024 * 2, 256 * 1024 * 2);
                EpiHgIn E{(const float*)(ws + WS_MISC + MISC_LB), (bf16*)(ws + A_QT_HG), (bf16*)(ws + A_KT_HG), (bf16*)(ws + A_KH_HG), (bf16*)(ws + A_V_HG), (bf16*)(ws + A_SZ_HG), (float*)(ws + A_E_HG)};
                pg8::gemm_phase<pg8::Cfg<128, 128 * 1024 * 2, 128, 128 * 1024 * 2, 16>, EpiHgIn, StdOrder, true, true>(lds + RING_OFF, g, vA, vB, S, E);
            }
            else if (op == OP_HG1) {
                unsigned char* ws = gptr(lds, I_WS);
                hg_phase<false>(lds + RING_OFF, (const bf16*)(ws + A_QT_HG), (const bf16*)(ws + A_KT_HG), (const bf16*)(ws + A_KH_HG), (const bf16*)(ws + A_V_HG), (const bf16*)(ws + A_SZ_HG), (const float*)(ws + A_E_HG),
                                (float*)(ws + A_ST_HG), (float*)(ws + A_DD_HG), (const float*)gptr(lds, I_HGNORM), (bf16*)(ws + A_Y2_HG), GRID, VCU);
            }
            else if (op == OP_HG2) {
                unsigned char* ws = gptr(lds, I_WS);
                hg_scan((float*)(ws + A_ST_HG), (const float*)(ws + A_DD_HG), GRID, BX);
            }
            else if (op == OP_HG3) {
                unsigned char* ws = gptr(lds, I_WS);
                hg_phase<true>(lds + RING_OFF, (const bf16*)(ws + A_QT_HG), (const bf16*)(ws + A_KT_HG), (const bf16*)(ws + A_KH_HG), (const bf16*)(ws + A_V_HG), (const bf16*)(ws + A_SZ_HG), (const float*)(ws + A_E_HG),
                                (float*)(ws + A_ST_HG), (float*)(ws + A_DD_HG), (const float*)gptr(lds, I_HGNORM), (bf16*)(ws + A_Y2_HG), GRID, VCU);
            }
            else if (op == OP_ATIN) {
                unsigned char* ws = gptr(lds, I_WS);
                unsigned vA, vB; VOFF_ROWMAJOR(vA, 1024, false); VOFF_ROWMAJOR(vB, 1024, false);
                pg8::Gemm g{(const char*)(ws + A_XN), (const char*)(ws + WS_W_ATIN)};
                StdOrder S; S.init(M, 2560, GRID, BX, 256 * 1024 * 2, 256 * 1024 * 2);
                EpiAtIn E{(const float*)gptr(lds, I_ATBIN), (const float*)(ws + WS_ROPE), (const float*)(ws + WS_ROPE) + (size_t)M * 32, (bf16*)(ws + A_Q_AT), (bf16*)(ws + A_K_AT), (bf16*)(ws + A_V_AT), (bf16*)(ws + A_SZ_AT)};
                pg8::gemm_phase<pg8::Cfg<128, 128 * 1024 * 2, 128, 128 * 1024 * 2, 16>, EpiAtIn, StdOrder, true, true>(lds + RING_OFF, g, vA, vB, S, E);
            }
            else if (op == OP_ATT) {
                unsigned char* ws = gptr(lds, I_WS);
                attn_phase(lds + RING_OFF, (const bf16*)(ws + A_Q_AT), (const bf16*)(ws + A_K_AT), (const bf16*)(ws + A_V_AT), (const bf16*)(ws + A_SZ_AT), (bf16*)(ws + A_Y2_AT), (const float*)gptr(lds, I_ATSINK), GRID, VCU);
            }
        else if (op == OP_OUT) {
            unsigned char* ws = gptr(lds, I_WS);
            const size_t a_y2 = (kind == 0) ? A_Y2_S5 : (kind == 1) ? A_Y2_HG : A_Y2_AT, a_w = (kind == 0) ? (jj ? WS_W_S5OUT1 : WS_W_S5OUT0) : (kind == 1) ? WS_W_HGOUT : WS_W_ATOUT, a_out = (kind == 0) ? A_OUT_S5 : (kind == 1) ? A_OUT_HG : A_OUT_AT;
            unsigned vA, vB; VOFF_ROWMAJOR(vA, 1024, false); VOFF_ROWMAJOR(vB, 1024, false);
            pg8::Gemm g{(const char*)(ws + a_y2), (const char*)(ws + a_w)};
            StdOrder S; S.init(M, 1024, GRID, BX, 256 * 1024 * 2, 256 * 1024 * 2);
            EpiF32 E{(float*)(ws + a_out)};
            pg8::gemm_phase<pg8::Cfg<128, 128 * 1024 * 2, 128, 128 * 1024 * 2, 16>, EpiF32, StdOrder, true, true>(lds + RING_OFF, g, vA, vB, S, E);
        }
        else if (op == OP_NORM) {
            unsigned char* ws = gptr(lds, I_WS); const int lane = LANE;
            const size_t a_out = (kind == 0) ? A_OUT_S5 : (kind == 1) ? A_OUT_HG : A_OUT_AT;
            const float* OB = (const float*)(ws + a_out); float* hout = (float*)gptr(lds, I_OUT); const float* hsrc = (layer == 0) ? (const float*)gptr(lds, I_X) : hout; bf16* XN = (bf16*)(ws + (layer == 0 ? A_XN_HG : A_XN));
            const float* gpost = (const float*)gptr(lds, I_NPOST) + layer * 1024; const float* gpre = (const float*)gptr(lds, I_NPRE) + (layer < 3 ? layer + 1 : 0) * 1024;
            for (int m = GW; m < M; m += NGW) { const f32x4* orow = (const f32x4*)(OB + (size_t)m * 1024) + lane; const f32x4* hrow = (const f32x4*)(hsrc + (size_t)m * 1024) + lane;
                f32x4 o[4], h[4]; float ss = 0.f;
#pragma unroll
                for (int j = 0; j < 4; ++j) { o[j] = orow[64 * j]; h[j] = hrow[64 * j]; ss += (o[j].x * o[j].x + o[j].y * o[j].y) + (o[j].z * o[j].z + o[j].w * o[j].w); }
                const float rs = 1.f / sqrtf(wave_sum(ss) * (1.f / 1024.f) + NORM_EPS); float s2 = 0.f;
                f32x4* hd = (f32x4*)(hout + (size_t)m * 1024) + lane;
#pragma unroll
                for (int j = 0; j < 4; ++j) { const f32x4 gp = ((const f32x4*)gpost)[lane + 64 * j]; h[j] = h[j] + o[j] * rs * gp; hd[64 * j] = h[j];
                    s2 += (h[j].x * h[j].x + h[j].y * h[j].y) + (h[j].z * h[j].z + h[j].w * h[j].w); }
                if (layer < 3) { const float r2 = 1.f / sqrtf(wave_sum(s2) * (1.f / 1024.f) + NORM_EPS); v2u* o8 = (v2u*)(XN + (size_t)m * 1024) + lane;
#pragma unroll
                    for (int j = 0; j < 4; ++j) { const f32x4 gg = ((const f32x4*)gpre)[lane + 64 * j]; v2u w; w.x = pk2(h[j].x * r2 * gg.x, h[j].y * r2 * gg.y); w.y = pk2(h[j].z * r2 * gg.z, h[j].w * r2 * gg.w); o8[64 * j] = w; } } }
        }
        if (ph + 1 < hi) xcd_barrier(bar);
    }
}

extern "C" void kernel_launch(void* const* d_in, const int* in_sizes, int n_in, void* d_out, int out_size, void* d_ws, size_t ws_size, hipStream_t stream) {
    static int grid = 0;
    if (grid == 0) {
        if (n_in != 24 || out_size != M * DM || ws_size < WS_END) { fprintf(stderr, "kernel_launch: unexpected sizes n_in %d out %d ws %zu\n", n_in, out_size, ws_size); grid = -1; return; }
        int dev = 0, cus = 0, per_cu = 0;
        if (hipGetDevice(&dev) != hipSuccess || hipDeviceGetAttribute(&cus, hipDeviceAttributeMultiprocessorCount, dev) != hipSuccess) { grid = -1; return; }
        if (hipFuncSetAttribute((const void*)mk_fwd, hipFuncAttributeMaxDynamicSharedMemorySize, LDS_BYTES) != hipSuccess) { fprintf(stderr, "kernel_launch: hipFuncSetAttribute failed\n"); grid = -1; return; }
        if (hipOccupancyMaxActiveBlocksPerMultiprocessor(&per_cu, (const void*)mk_fwd, NWAVES * 64, LDS_BYTES) != hipSuccess || per_cu < 1) { fprintf(stderr, "kernel_launch: occupancy query says %d blocks per CU\n", per_cu); (void)hipGetLastError(); grid = -1; return; }
        grid = cus;
    }
    if (grid < 0) return;
    (void)hipMemsetAsync((char*)d_ws + WS_CTL, 0, CTL_ZERO_BYTES, stream);
    Args a{};
    for (int i = 0; i < 24; ++i) a.in[i] = d_in[i];
    a.out = (float*)d_out; a.ws = (unsigned char*)d_ws;
#if MK_N_LAUNCHES == 1
    a.ph_lo = 0; a.ph_hi = NPHASES;
    hipLaunchKernelGGL(mk_fwd, dim3(grid), dim3(NWAVES * 64), LDS_BYTES, stream, a);
#else
    for (int p = 0; p < NPHASES; ++p) { a.ph_lo = p; a.ph_hi = p + 1; hipLaunchKernelGGL(mk_fwd, dim3(grid), dim3(NWAVES * 64), LDS_BYTES, stream, a); }
#endif
}
```
